# Optimizing an MI355X kernel written in HIP

```python
import jax
import jax.numpy as jnp
from jax import lax
import numpy as np

D_MODEL = 1024
BATCH = 16
SEQ = 2048
DEPTH = 4

CTX_LEN = 256
GRID_W = 64
N_HEADS = 16
HEAD_DIM = D_MODEL // N_HEADS
D_FF = 2816
N_MIXERS = 2
NA_KH_MAX = 8
NA_KW = 16
NA_QC = 16
NA_KBW = 2 * NA_KW
CONV_W = 3
ROPE_BASE = 10000.0
N_MOD = 9
N_NA_LAYERS = (DEPTH + N_MIXERS - 1) // N_MIXERS
N_CONV_LAYERS = DEPTH // N_MIXERS
DN_ALPHA = (2.0 * DEPTH) ** 0.25
DN_BETA = (8.0 * DEPTH) ** -0.25
LN_EPS = 1e-6

kernel_name = "hybrid_natten_shortconv_deepnorm_dit"


def layer_norm(x, g, b):
    xf = x.astype(jnp.float32)
    mu = jnp.mean(xf, axis=-1, keepdims=True)
    var = jnp.mean(jnp.square(xf - mu), axis=-1, keepdims=True)
    return ((xf - mu) * lax.rsqrt(var + LN_EPS)).astype(x.dtype) * g + b


def modulate(x, shift, scale):
    return x * (1 + scale) + shift


def post_norm_update(x, y, gate, res_w, g, b):
    return layer_norm(DN_ALPHA * x + res_w * gate * y, g, b)


def swiglu_ffn(h, w_in, w_out):
    a, u = jnp.split(h @ w_in, 2, axis=-1)
    return (jax.nn.silu(a) * u) @ w_out


def half_step_ffn(x, shift, scale, gate, w_in, w_out, g, b):
    y = swiglu_ffn(modulate(x, shift, scale), w_in, w_out)
    return post_norm_update(x, y, gate, 0.5, g, b)


def axial_rope_tables(n_tok):
    t = np.arange(n_tok)
    n_freq = HEAD_DIM // 4
    inv_freq = ROPE_BASE ** (-np.arange(n_freq) / n_freq)
    ang_row = (t // GRID_W)[:, None] * inv_freq[None]
    ang_col = (t % GRID_W)[:, None] * inv_freq[None]
    return (jnp.asarray(np.cos(ang_row), jnp.float32), jnp.asarray(np.sin(ang_row), jnp.float32),
            jnp.asarray(np.cos(ang_col), jnp.float32), jnp.asarray(np.sin(ang_col), jnp.float32))


def _rotate(x, cos, sin):
    x1, x2 = jnp.split(x, 2, axis=-1)
    cos = cos[None, :, None, :].astype(x.dtype)
    sin = sin[None, :, None, :].astype(x.dtype)
    return jnp.concatenate([x1 * cos - x2 * sin, x2 * cos + x1 * sin], axis=-1)


def apply_axial_rope(x, tables):
    cos_r, sin_r, cos_c, sin_c = tables
    half = HEAD_DIM // 2
    return jnp.concatenate([_rotate(x[..., :half], cos_r, sin_r),
                            _rotate(x[..., half:], cos_c, sin_c)], axis=-1)


def neighbourhood_attention(hx, hc, w_qkv, w_out, rpb, rope, with_ctx_queries):
    B, S, D = hx.shape
    rows = S // GRID_W
    kh = min(NA_KH_MAX, rows)
    ncb = GRID_W // NA_QC
    nk = kh * NA_KBW
    scale = HEAD_DIM ** -0.5

    qkv = (hx @ w_qkv).reshape(B, S, 3, N_HEADS, HEAD_DIM)
    q = apply_axial_rope(qkv[:, :, 0], rope)
    k = apply_axial_rope(qkv[:, :, 1], rope)
    v = qkv[:, :, 2]
    qkv_c = (hc @ w_qkv).reshape(B, hc.shape[1], 3, N_HEADS, HEAD_DIM)
    q_c, k_c, v_c = qkv_c[:, :, 0], qkv_c[:, :, 1], qkv_c[:, :, 2]

    q_col = np.arange(ncb)[:, None] * NA_QC + np.arange(NA_QC)[None]
    win_c0 = np.clip(q_col - NA_KW // 2, 0, GRID_W - NA_KW)
    blk_c0 = np.clip(np.arange(ncb) * NA_QC - NA_KW // 2, 0, GRID_W - NA_KBW)
    key_col = blk_c0[:, None] + np.arange(NA_KBW)[None]
    col_ok = (key_col[:, None, :] >= win_c0[..., None]) & (key_col[:, None, :] < win_c0[..., None] + NA_KW)
    mask = jnp.asarray(np.broadcast_to(col_ok[:, :, None, :], (ncb, NA_QC, kh, NA_KBW)).reshape(ncb, NA_QC, nk))
    dx_idx = np.clip(key_col[:, None, :] - q_col[..., None] + NA_KW - 1, 0, 2 * NA_KW - 2)
    dx_b = np.broadcast_to(dx_idx[:, :, None, :], (ncb, NA_QC, kh, NA_KBW))

    k_grid = k.reshape(B, rows, GRID_W, N_HEADS, HEAD_DIM)
    v_grid = v.reshape(B, rows, GRID_W, N_HEADS, HEAD_DIM)
    q_rows = jnp.moveaxis(q.reshape(B, rows, ncb, NA_QC, N_HEADS, HEAD_DIM), 1, 0)

    def row_block(args):
        r, q_r = args
        rs = jnp.clip(r - kh // 2, 0, rows - kh)
        k_rows = lax.dynamic_slice_in_dim(k_grid, rs, kh, axis=1)
        v_rows = lax.dynamic_slice_in_dim(v_grid, rs, kh, axis=1)
        k_blk = jnp.moveaxis(k_rows[:, :, key_col], 2, 1).reshape(B, ncb, nk, N_HEADS, HEAD_DIM)
        v_blk = jnp.moveaxis(v_rows[:, :, key_col], 2, 1).reshape(B, ncb, nk, N_HEADS, HEAD_DIM)
        dy_idx = rs + jnp.arange(kh) - r + NA_KH_MAX - 1
        bias = rpb[:, dy_idx[None, None, :, None], dx_b].reshape(N_HEADS, ncb, NA_QC, nk)
        s_win = jnp.einsum('bjqhd,bjkhd->bhjqk', q_r, k_blk).astype(jnp.float32) * scale
        s_win = jnp.where(mask, s_win + bias.astype(jnp.float32)[None], -jnp.inf)
        s_ctx = jnp.einsum('bjqhd,bchd->bhjqc', q_r, k_c).astype(jnp.float32) * scale
        p = jax.nn.softmax(jnp.concatenate([s_win, s_ctx], axis=-1), axis=-1).astype(v.dtype)
        return (jnp.einsum('bhjqk,bjkhd->bjqhd', p[..., :nk], v_blk)
                + jnp.einsum('bhjqc,bchd->bjqhd', p[..., nk:], v_c))

    o = lax.map(row_block, (jnp.arange(rows), q_rows))
    y_lat = jnp.moveaxis(o, 0, 1).reshape(B, S, D) @ w_out

    y_ctx = None
    if with_ctx_queries:
        s = jnp.einsum('bqhd,bkhd->bhqk', q_c, k_c).astype(jnp.float32) * scale
        p = jax.nn.softmax(s, axis=-1).astype(v_c.dtype)
        y_ctx = jnp.einsum('bhqk,bkhd->bqhd', p, v_c).reshape(B, hc.shape[1], D) @ w_out
    return y_lat, y_ctx


def short_conv_mixer(h, w_in, conv_w, w_out):
    b_gate, c_gate, hv = jnp.split(h @ w_in, 3, axis=-1)
    u = c_gate * hv
    n = u.shape[1]
    pad = CONV_W // 2
    up = jnp.pad(u, ((0, 0), (pad, pad), (0, 0)))
    y = conv_w[0] * up[:, 0:n]
    for j in range(1, CONV_W):
        y = y + conv_w[j] * up[:, j:j + n]
    return (b_gate * y) @ w_out


def setup_inputs(seed: int = 0) -> dict:
    key = jax.random.key(seed)
    ks = jax.random.split(key, 16)
    D, F = D_MODEL, D_FF

    def nrm(k, shape, s):
        return jax.random.normal(k, shape, jnp.float32) * s

    return {
        "x": nrm(ks[0], (BATCH, SEQ, D), 1.0),
        "c": nrm(ks[1], (BATCH, D), 1.0),
        "ctx": nrm(ks[2], (BATCH, CTX_LEN, D), 1.0),
        "c_ctx": nrm(ks[3], (D,), 1.0),
        "ada_w": nrm(ks[4], (DEPTH, D, N_MOD * D), 0.5 * D ** -0.5),
        "ada_b": nrm(ks[5], (DEPTH, N_MOD * D), 0.02),
        "ln_g": 1.0 + nrm(ks[6], (DEPTH, 3, D), 0.02),
        "ln_b": nrm(ks[7], (DEPTH, 3, D), 0.02),
        "ffn_w_in": nrm(ks[8], (DEPTH, 2, D, 2 * F), D ** -0.5),
        "ffn_w_out": nrm(ks[9], (DEPTH, 2, F, D), DN_BETA * F ** -0.5),
        "na_w_qkv": nrm(ks[10], (N_NA_LAYERS, D, 3 * D), D ** -0.5),
        "na_w_out": nrm(ks[11], (N_NA_LAYERS, D, D), DN_BETA * D ** -0.5),
        "na_rpb": nrm(ks[12], (N_NA_LAYERS, N_HEADS, 2 * NA_KH_MAX - 1, 2 * NA_KW - 1), 0.1),
        "sc_w_in": nrm(ks[13], (N_CONV_LAYERS, D, 3 * D), D ** -0.5),
        "sc_conv": nrm(ks[14], (N_CONV_LAYERS, CONV_W, D), CONV_W ** -0.5),
        "sc_w_out": nrm(ks[15], (N_CONV_LAYERS, D, D), DN_BETA * D ** -0.5),
    }


def reference(x, c, ctx, c_ctx, ada_w, ada_b, ln_g, ln_b, ffn_w_in, ffn_w_out,
              na_w_qkv, na_w_out, na_rpb, sc_w_in, sc_conv, sc_w_out):
    B, S, D = x.shape
    rope = axial_rope_tables(S)
    last_na = max(range(0, DEPTH, N_MIXERS))
    s_c = jax.nn.silu(c)
    s_cc = jax.nn.silu(c_ctx)
    for i in range(DEPTH):
        ctx_in = i <= last_na
        ctx_out = i < last_na
        j = i // N_MIXERS
        m = (s_c @ ada_w[i] + ada_b[i]).reshape(B, N_MOD, 1, D)
        mc = (s_cc @ ada_w[i] + ada_b[i]).reshape(N_MOD, D)

        x = half_step_ffn(x, m[:, 0], m[:, 1], m[:, 2], ffn_w_in[i, 0], ffn_w_out[i, 0], ln_g[i, 0], ln_b[i, 0])
        if ctx_in:
            ctx = half_step_ffn(ctx, mc[0], mc[1], mc[2], ffn_w_in[i, 0], ffn_w_out[i, 0], ln_g[i, 0], ln_b[i, 0])

        hx = modulate(x, m[:, 3], m[:, 4])
        y_ctx = None
        if i % N_MIXERS == 0:
            hc = modulate(ctx, mc[3], mc[4])
            y_lat, y_ctx = neighbourhood_attention(hx, hc, na_w_qkv[j], na_w_out[j], na_rpb[j], rope, ctx_out)
        else:
            y_lat = short_conv_mixer(hx, sc_w_in[j], sc_conv[j], sc_w_out[j])
            if ctx_out:
                y_ctx = short_conv_mixer(modulate(ctx, mc[3], mc[4]), sc_w_in[j], sc_conv[j], sc_w_out[j])
        x = post_norm_update(x, y_lat, m[:, 5], 1.0, ln_g[i, 1], ln_b[i, 1])
        if ctx_out:
            ctx = post_norm_update(ctx, y_ctx, mc[5], 1.0, ln_g[i, 1], ln_b[i, 1])

        x = half_step_ffn(x, m[:, 6], m[:, 7], m[:, 8], ffn_w_in[i, 1], ffn_w_out[i, 1], ln_g[i, 2], ln_b[i, 2])
        if ctx_out:
            ctx = half_step_ffn(ctx, mc[6], mc[7], mc[8], ffn_w_in[i, 1], ffn_w_out[i, 1], ln_g[i, 2], ln_b[i, 2])
    return x
```

```cpp
#include <hip/hip_runtime.h>
#include <hip/hip_cooperative_groups.h>
#include <cstdio>
#include <cstdint>
#include <cmath>
namespace cg = cooperative_groups;
namespace pg8 {
#define PG8_LAS __attribute__((address_space(3)))
typedef unsigned short bf16_t;
typedef short bf16x8 __attribute__((ext_vector_type(8)));
typedef float f32x4 __attribute__((ext_vector_type(4)));
typedef unsigned u32x4 __attribute__((ext_vector_type(4)));
constexpr int BM = 256, BK = 64, HALF = 128, HTB = HALF * BK * 2  , STAGE_BYTES = 8 * HTB, NXCD = 8, WGM = 8;

__host__ __device__ __forceinline__ int lds_byte(int r, int c) { const int st = (r >> 4) * 2 + (c >> 5), rr = r & 15, cc = c & 31, ob = rr * 64 + cc * 2; return st * 1024 + (ob ^ (((ob >> 9) & 1) << 5)); }
__host__ __device__ __forceinline__ void stage_rc(int b, int& R, int& C) { const int st = b / 1024, sb = b % 1024, swz = sb ^ (((sb >> 9) & 1) << 5); R = (st >> 1) * 16 + swz / 64; C = (st & 1) * 32 + (swz % 64) / 2; }
__host__ __device__ __forceinline__ int perm32(int rho) { const int n = rho >> 4, i = rho & 15; return 8 * (i >> 2) + 4 * n + (i & 3); }

struct Unit { int pm, pn; };
struct Gemm { const bf16_t* A; const bf16_t* Bt; int M, N, K; };

struct StaticOrder {
    int nM, nN, nwg, G, c;
    __host__ __device__ void init(int M, int N, int G_, int c_) { nM = M / BM; nN = N / BM; nwg = nM * nN; G = G_; c = c_; }
    __host__ __device__ bool next(int i, Unit& u) const {
        const long L = (long)i * G + c; if (L >= nwg) return false;
        int wgid = (int)L; { const int q = nwg / NXCD, r = nwg % NXCD, xcd = wgid % NXCD, off = wgid / NXCD; wgid = (xcd < r ? xcd * (q + 1) : r * (q + 1) + (xcd - r) * q) + off; }
        const int nig = WGM * nN, gid = wgid / nig, fm = gid * WGM, gsz = (nM - fm) < WGM ? (nM - fm) : WGM;
        u.pm = fm + ((wgid % nig) % gsz); u.pn = (wgid % nig) / gsz; return true;
    }
    __device__ __forceinline__ void a_ready(const Unit&) const {}
    __device__ __forceinline__ void done(const Unit&) const {}
};

__device__ __forceinline__ unsigned cvt_pk_bf16(float lo, float hi) { unsigned r; asm volatile("v_cvt_pk_bf16_f32 %0, %1, %2" : "=v"(r) : "v"(lo), "v"(hi)); return r; }
__device__ __forceinline__ unsigned cvt_pk_bf16_safe(float lo, float hi) { unsigned r; asm volatile("s_nop 1\n\tv_cvt_pk_bf16_f32 %0, %1, %2\n\ts_nop 1" : "=v"(r) : "v"(lo), "v"(hi)); return r; }
typedef float f32x2 __attribute__((ext_vector_type(2)));
typedef unsigned u32x2 __attribute__((ext_vector_type(2)));
constexpr int EP_TL = 32768;
constexpr int EP_MODSET = 9 * 1024;

struct EpiStoreBf16 {
    static constexpr bool PERM = true, AFTER_DRAIN = false;
    bf16_t* O; int ldc;
    __device__ __forceinline__ void operator()(const f32x4 (&acc)[2][2][4][2], const Unit& u, int wr, int wc, int fr, int fq) const {
        const int row0 = u.pm * BM + wr * 64 + fr, col0 = u.pn * BM + wc * 32 + 8 * fq;
#pragma unroll
        for (int ai = 0; ai < 2; ++ai)
#pragma unroll
            for (int m = 0; m < 4; ++m) { bf16_t* rowp = O + (size_t)(row0 + ai * HALF + m * 16) * ldc + col0;
#pragma unroll
                for (int bj = 0; bj < 2; ++bj) { const f32x4 v0 = acc[ai][bj][m][0], v1 = acc[ai][bj][m][1];
                    u32x4 w; w.x = cvt_pk_bf16(v0[0], v0[1]); w.y = cvt_pk_bf16(v0[2], v0[3]); w.z = cvt_pk_bf16(v1[0], v1[1]); w.w = cvt_pk_bf16(v1[2], v1[3]);
                    *(u32x4*)(rowp + bj * HALF) = w; } }
    }
};
__device__ __forceinline__ float silu_mul(float a, float u) {
    const float e = __builtin_amdgcn_exp2f(a * -1.44269504089f);
    return a * __builtin_amdgcn_rcpf(1.0f + e) * u;
}
struct EpiSwiglu {
    static constexpr bool PERM = true, AFTER_DRAIN = false;
    bf16_t* O; int ldc;
    __device__ __forceinline__ void operator()(const f32x4 (&acc)[2][2][4][2], const Unit& u, int wr, int wc, int fr, int fq) const {
        const int row0 = u.pm * BM + wr * 64 + fr, col0 = u.pn * HALF + wc * 32 + 8 * fq;
#pragma unroll
        for (int ai = 0; ai < 2; ++ai)
#pragma unroll
            for (int m = 0; m < 4; ++m) { bf16_t* rowp = O + (size_t)(row0 + ai * HALF + m * 16) * ldc + col0;
                const f32x4 a0 = acc[ai][0][m][0], a1 = acc[ai][0][m][1], u0 = acc[ai][1][m][0], u1 = acc[ai][1][m][1];
                u32x4 w;
                w.x = cvt_pk_bf16(silu_mul(a0[0], u0[0]), silu_mul(a0[1], u0[1])); w.y = cvt_pk_bf16(silu_mul(a0[2], u0[2]), silu_mul(a0[3], u0[3]));
                w.z = cvt_pk_bf16(silu_mul(a1[0], u1[0]), silu_mul(a1[1], u1[1])); w.w = cvt_pk_bf16(silu_mul(a1[2], u1[2]), silu_mul(a1[3], u1[3]));
                *(u32x4*)rowp = w; }
    }
};
struct EpiConvIn {
    static constexpr bool PERM = true, AFTER_DRAIN = false;
    bf16_t* U; bf16_t* Bg;
    __device__ __forceinline__ void operator()(const f32x4 (&acc)[2][2][4][2], const Unit& u, int wr, int wc, int fr, int fq) const {
        const int row0 = u.pm * BM + wr * 64 + fr;
        if (u.pn < 8) {
            const int col0 = u.pn * HALF + wc * 32 + 8 * fq;
#pragma unroll
            for (int ai = 0; ai < 2; ++ai)
#pragma unroll
                for (int m = 0; m < 4; ++m) { bf16_t* rowp = U + (size_t)(row0 + ai * HALF + m * 16) * 1024 + col0;
                    const f32x4 p0 = acc[ai][0][m][0] * acc[ai][1][m][0], p1 = acc[ai][0][m][1] * acc[ai][1][m][1];
                    u32x4 w; w.x = cvt_pk_bf16(p0[0], p0[1]); w.y = cvt_pk_bf16(p0[2], p0[3]); w.z = cvt_pk_bf16(p1[0], p1[1]); w.w = cvt_pk_bf16(p1[2], p1[3]);
                    *(u32x4*)rowp = w; }
        } else {
            const int col0 = (u.pn - 8) * BM + wc * 32 + 8 * fq;
#pragma unroll
            for (int ai = 0; ai < 2; ++ai)
#pragma unroll
                for (int m = 0; m < 4; ++m) { bf16_t* rowp = Bg + (size_t)(row0 + ai * HALF + m * 16) * 1024 + col0;
#pragma unroll
                    for (int bj = 0; bj < 2; ++bj) { const f32x4 v0 = acc[ai][bj][m][0], v1 = acc[ai][bj][m][1];
                        u32x4 w; w.x = cvt_pk_bf16(v0[0], v0[1]); w.y = cvt_pk_bf16(v0[2], v0[3]); w.z = cvt_pk_bf16(v1[0], v1[1]); w.w = cvt_pk_bf16(v1[2], v1[3]);
                        *(u32x4*)(rowp + bj * HALF) = w; } }
        }
    }
};
struct EpiQK {
    static constexpr bool PERM = false, AFTER_DRAIN = false;
    bf16_t* Q; bf16_t* K; const float* cosT; const float* sinT;
    __device__ __forceinline__ void operator()(const f32x4 (&acc)[2][2][4][2], const Unit& u, int wr, int wc, int fr, int fq) const {
        const bool isq = u.pn < 4; bf16_t* base = isq ? Q : K; const float sc = isq ? 0.125f : 1.0f;
        const int row0 = u.pm * BM + wr * 64 + fr, col0 = (u.pn & 3) * BM + wc * 32 + 4 * fq;
#pragma unroll
        for (int ai = 0; ai < 2; ++ai)
#pragma unroll
            for (int m = 0; m < 4; ++m) { const int row = row0 + ai * HALF + m * 16;
                f32x4 c4 = (f32x4){1.f, 1.f, 1.f, 1.f}, s4 = (f32x4){0.f, 0.f, 0.f, 0.f};
                if (row < EP_TL) { const int t = row & 2047, pos = (wc & 1) ? (t & 63) : (t >> 6);
                    c4 = *(const f32x4*)(cosT + pos * 16 + 4 * fq); s4 = *(const f32x4*)(sinT + pos * 16 + 4 * fq); }
                c4 = c4 * sc; s4 = s4 * sc;
                bf16_t* rowp = base + (size_t)row * 1024 + col0;
#pragma unroll
                for (int bj = 0; bj < 2; ++bj) { const f32x4 x1 = acc[ai][bj][m][0], x2 = acc[ai][bj][m][1];
                    const f32x4 o1 = x1 * c4 - x2 * s4, o2 = x2 * c4 + x1 * s4;
                    u32x2 w1, w2; w1.x = cvt_pk_bf16(o1[0], o1[1]); w1.y = cvt_pk_bf16(o1[2], o1[3]); w2.x = cvt_pk_bf16(o2[0], o2[1]); w2.y = cvt_pk_bf16(o2[2], o2[3]);
                    *(u32x2*)(rowp + bj * HALF) = w1; *(u32x2*)(rowp + bj * HALF + 16) = w2; }
                if (m & 1) asm volatile("" ::: "memory"); }
    }
};
struct EpiRes {
    static constexpr bool PERM = false, AFTER_DRAIN = false;
    float* Z; const float* stats; const float* g; const float* b; const float* gate; float w, alpha;
    __device__ __forceinline__ void operator()(const f32x4 (&acc)[2][2][4][2], const Unit& u, int wr, int wc, int fr, int fq) const {
        const int row0 = u.pm * BM + wr * 64 + fr, col0 = u.pn * BM + wc * 32 + 4 * fq;
        const int set = u.pm < (EP_TL / BM) ? (u.pm >> 3) : 16;
        const float* gp = gate + (size_t)set * EP_MODSET + col0;
        f32x2 st[2][4];
#pragma unroll
        for (int ai = 0; ai < 2; ++ai)
#pragma unroll
            for (int m = 0; m < 4; ++m) st[ai][m] = *(const f32x2*)(stats + 2 * (size_t)(row0 + ai * HALF + m * 16));
#pragma unroll
        for (int bj = 0; bj < 2; ++bj)
#pragma unroll
            for (int n = 0; n < 2; ++n) { const int co = bj * HALF + n * 16;
                const f32x4 gv = *(const f32x4*)(g + col0 + co), bv = *(const f32x4*)(b + col0 + co); f32x4 gt = *(const f32x4*)(gp + co); gt = gt * w;
#pragma unroll
                for (int ai = 0; ai < 2; ++ai)
#pragma unroll
                    for (int m = 0; m < 4; ++m) { float* zp = Z + (size_t)(row0 + ai * HALF + m * 16) * 1024 + col0 + co;
                        const f32x4 z = *(const f32x4*)zp; const f32x4 x = (z - st[ai][m].x) * st[ai][m].y * gv + bv;
                        *(f32x4*)zp = x * alpha + gt * acc[ai][bj][m][n]; } }
    }
};

template <class Epi, class Sched, bool ALIGN_EPI = false, bool SP2 = false>
__device__ __forceinline__ void gemm_phase(PG8_LAS unsigned char* lds, const Gemm g, const Sched& S, const Epi& E, const int tid_in) {
    const int tid = tid_in, wid = __builtin_amdgcn_readfirstlane(tid >> 6), lane = tid & 63, wr = wid >> 2, wc = wid & 3, fr = lane & 15, fq = lane >> 4;
    const int K = g.K, nt = K / BK;
    unsigned voffA[2], voffB[2];
#pragma unroll
    for (int i = 0; i < 2; ++i) { int R, C; stage_rc(tid * 16 + i * 8192, R, C); const int Rb = Epi::PERM ? ((R & ~31) + perm32(R & 31)) : R;
        voffA[i] = (unsigned)(R * K + C) * 2u; voffB[i] = (unsigned)(Rb * K + C) * 2u; }
    const size_t kstep = (size_t)(BK * 2);
    const size_t hstep = (size_t)HALF * K * 2;
    const size_t tstep = 2 * hstep;
    const unsigned ldsw = (unsigned)wid * 1024u;
    const int aoff = lds_byte(wr * 64 + fr, fq * 8), boff = lds_byte(wc * 32 + fr, fq * 8);
#define PG8_SA(b, h) (((b) * 2 + (h)) * HTB)
#define PG8_SB(b, h) ((4 + (b) * 2 + (h)) * HTB)
#define PG8_STAGE(bufoff, gbase, voff) do { _Pragma("unroll") for (int _i = 0; _i < 2; ++_i) \
        __builtin_amdgcn_global_load_lds((const unsigned*)((const char*)(gbase) + (voff)[_i]), (PG8_LAS unsigned*)(lds + (bufoff) + ldsw + _i * 8192), 16, 0, 0); } while (0)
#define PG8_LDA(dst, b, h) do { _Pragma("unroll") for (int m = 0; m < 4; ++m) _Pragma("unroll") for (int k = 0; k < 2; ++k) dst[m][k] = *(const PG8_LAS bf16x8*)(lds + PG8_SA(b, h) + aoff + m * 2048 + k * 1024); } while (0)
#define PG8_LDB(dst, b, h) do { _Pragma("unroll") for (int n = 0; n < 2; ++n) _Pragma("unroll") for (int k = 0; k < 2; ++k) dst[n][k] = *(const PG8_LAS bf16x8*)(lds + PG8_SB(b, h) + boff + n * 2048 + k * 1024); } while (0)
#define PG8_MMA(ai, bj, At, Bt) do { __builtin_amdgcn_s_setprio(1); _Pragma("unroll") for (int m = 0; m < 4; ++m) _Pragma("unroll") for (int n = 0; n < 2; ++n) _Pragma("unroll") for (int k = 0; k < 2; ++k) \
        acc[ai][bj][m][n] = __builtin_amdgcn_mfma_f32_16x16x32_bf16(Bt[n][k], At[m][k], acc[ai][bj][m][n], 0, 0, 0); __builtin_amdgcn_s_setprio(0); } while (0)
#define PG8_WAIT_V(n) asm volatile("s_waitcnt vmcnt(" #n ")" ::: "memory")
#define PG8_WAIT_L(n) asm volatile("s_waitcnt lgkmcnt(" #n ")" ::: "memory")
#define PG8_BAR __builtin_amdgcn_s_barrier()
#define PG8_SCHED __builtin_amdgcn_sched_barrier(0)
    Unit cur, nxt; int ui = 0;
    if (!S.next(0, cur)) return;
    f32x4 acc[2][2][4][2];
#pragma unroll
    for (int a = 0; a < 2; ++a)
#pragma unroll
        for (int b = 0; b < 2; ++b)
#pragma unroll
            for (int m = 0; m < 4; ++m)
#pragma unroll
                for (int n = 0; n < 2; ++n) acc[a][b][m][n] = (f32x4){0.f, 0.f, 0.f, 0.f};
    bf16x8 At[4][2], B0[2][2], B1[2][2];
    const char* cA = (const char*)g.A + (size_t)cur.pm * tstep; const char* cB = (const char*)g.Bt + (size_t)cur.pn * tstep;
    S.a_ready(cur);
    if constexpr (SP2) {
        PG8_STAGE(PG8_SB(0, 0), cB, voffB); PG8_STAGE(PG8_SB(0, 1), cB + hstep, voffB); PG8_STAGE(PG8_SA(0, 0), cA, voffA); PG8_STAGE(PG8_SA(0, 1), cA + hstep, voffA);
        if (wr == 1) PG8_BAR;
        PG8_WAIT_V(2); PG8_BAR;
        PG8_STAGE(PG8_SB(1, 0), cB + kstep, voffB); PG8_STAGE(PG8_SA(1, 0), cA + kstep, voffA); PG8_STAGE(PG8_SB(1, 1), cB + hstep + kstep, voffB);
        PG8_WAIT_V(6); PG8_BAR;
    } else {
        PG8_STAGE(PG8_SB(0, 0), cB, voffB); PG8_STAGE(PG8_SA(0, 0), cA, voffA); PG8_STAGE(PG8_SB(0, 1), cB + hstep, voffB); PG8_STAGE(PG8_SA(0, 1), cA + hstep, voffA);
        if (wr == 1) PG8_BAR;
        PG8_WAIT_V(4); PG8_BAR;
        PG8_STAGE(PG8_SB(1, 0), cB + kstep, voffB); PG8_STAGE(PG8_SA(1, 0), cA + kstep, voffA); PG8_STAGE(PG8_SB(1, 1), cB + hstep + kstep, voffB);
        PG8_WAIT_V(6); PG8_BAR;
    }
    for (;;) {
        const bool has_next = S.next(ui + 1, nxt);
        const char* nA = has_next ? (const char*)g.A + (size_t)nxt.pm * tstep : cA; const char* nB = has_next ? (const char*)g.Bt + (size_t)nxt.pn * tstep : cB;
        for (int t = 0; t < nt; t += 2) {
            const bool last = (t == nt - 2);
            const char* a1 = cA + (size_t)(t + 1) * kstep;
            const char* a2 = last ? nA : cA + (size_t)(t + 2) * kstep; const char* b2 = last ? nB : cB + (size_t)(t + 2) * kstep;
            const char* a3 = a2 + kstep; const char* b3 = b2 + kstep;
            if (last && has_next) S.a_ready(nxt);
            if constexpr (SP2) {
            PG8_LDB(B0, 0, 0); PG8_LDB(B1, 0, 1); PG8_SCHED; PG8_LDA(At, 0, 0); PG8_STAGE(PG8_SA(1, 1), a1 + hstep, voffA);
            PG8_WAIT_V(8); PG8_WAIT_L(0); PG8_BAR; PG8_MMA(0, 0, At, B0); PG8_MMA(0, 1, At, B1); PG8_BAR; PG8_SCHED;
            PG8_LDA(At, 0, 1); PG8_STAGE(PG8_SB(0, 0), b2, voffB); PG8_STAGE(PG8_SB(0, 1), b2 + hstep, voffB); PG8_STAGE(PG8_SA(0, 0), a2, voffA);
            PG8_WAIT_V(8); PG8_WAIT_L(0); PG8_BAR; PG8_MMA(1, 0, At, B0); PG8_MMA(1, 1, At, B1); PG8_BAR; PG8_SCHED;
            PG8_LDB(B0, 1, 0); PG8_LDB(B1, 1, 1); PG8_SCHED; PG8_LDA(At, 1, 0); PG8_STAGE(PG8_SA(0, 1), a2 + hstep, voffA);
            PG8_WAIT_V(8); PG8_WAIT_L(0); PG8_BAR; PG8_MMA(0, 0, At, B0); PG8_MMA(0, 1, At, B1); PG8_BAR; PG8_SCHED;
            PG8_LDA(At, 1, 1); PG8_STAGE(PG8_SB(1, 0), b3, voffB); PG8_STAGE(PG8_SB(1, 1), b3 + hstep, voffB); PG8_STAGE(PG8_SA(1, 0), a3, voffA);
            PG8_WAIT_V(8); PG8_WAIT_L(0); PG8_BAR; PG8_MMA(1, 0, At, B0); PG8_MMA(1, 1, At, B1); PG8_BAR; PG8_SCHED;
            } else {
            PG8_LDB(B0, 0, 0); PG8_SCHED; PG8_LDA(At, 0, 0); PG8_STAGE(PG8_SA(1, 1), a1 + hstep, voffA);
            PG8_WAIT_L(8); PG8_BAR; PG8_WAIT_L(0); PG8_MMA(0, 0, At, B0); PG8_BAR; PG8_SCHED;
            PG8_LDB(B1, 0, 1); PG8_STAGE(PG8_SB(0, 0), b2, voffB);
            PG8_BAR; PG8_WAIT_L(0); PG8_MMA(0, 1, At, B1); PG8_BAR;
            PG8_LDA(At, 0, 1); PG8_STAGE(PG8_SA(0, 0), a2, voffA);
            PG8_BAR; PG8_WAIT_L(0); PG8_MMA(1, 0, At, B0); PG8_BAR; PG8_SCHED;
            PG8_STAGE(PG8_SB(0, 1), b2 + hstep, voffB);
            PG8_WAIT_V(6); PG8_BAR; PG8_MMA(1, 1, At, B1); PG8_BAR;
            PG8_LDB(B0, 1, 0); PG8_SCHED; PG8_LDA(At, 1, 0); PG8_STAGE(PG8_SA(0, 1), a2 + hstep, voffA);
            PG8_WAIT_L(8); PG8_BAR; PG8_WAIT_L(0); PG8_MMA(0, 0, At, B0); PG8_BAR; PG8_SCHED;
            PG8_LDB(B1, 1, 1); PG8_STAGE(PG8_SB(1, 0), b3, voffB);
            PG8_BAR; PG8_WAIT_L(0); PG8_MMA(0, 1, At, B1); PG8_BAR;
            PG8_LDA(At, 1, 1); PG8_STAGE(PG8_SA(1, 0), a3, voffA);
            PG8_BAR; PG8_WAIT_L(0); PG8_MMA(1, 0, At, B0); PG8_BAR; PG8_SCHED;
            PG8_STAGE(PG8_SB(1, 1), b3 + hstep, voffB);
            PG8_WAIT_V(6); PG8_BAR; PG8_MMA(1, 1, At, B1); PG8_BAR;
            }
        }
        if constexpr (ALIGN_EPI) { if (wr == 0) PG8_BAR; }
        if constexpr (!Epi::AFTER_DRAIN) { E(acc, cur, wr, wc, fr, fq); S.done(cur); }
        if (!has_next) break;
#pragma unroll
        for (int a = 0; a < 2; ++a)
#pragma unroll
            for (int b = 0; b < 2; ++b)
#pragma unroll
                for (int m = 0; m < 4; ++m)
#pragma unroll
                    for (int n = 0; n < 2; ++n) acc[a][b][m][n] = (f32x4){0.f, 0.f, 0.f, 0.f};
        cur = nxt; cA = nA; cB = nB; ++ui;
        if constexpr (ALIGN_EPI) { if (wr == 1) PG8_BAR; }
    }
    PG8_WAIT_V(0);
    if constexpr (!ALIGN_EPI) { if (wr == 0) PG8_BAR; }
    PG8_BAR;
    if constexpr (Epi::AFTER_DRAIN) { E.fused(acc, cur, wr, wc, fr, fq, lds, wid, lane); S.done(cur); }
#undef PG8_SA
#undef PG8_SB
#undef PG8_STAGE
#undef PG8_LDA
#undef PG8_LDB
#undef PG8_MMA
#undef PG8_WAIT_V
#undef PG8_WAIT_L
#undef PG8_BAR
#undef PG8_SCHED
}
}

#define LAS __attribute__((address_space(3)))
typedef unsigned short bf16;
typedef float f32x4 __attribute__((ext_vector_type(4)));
typedef float f32x2 __attribute__((ext_vector_type(2)));
typedef short bf16x8 __attribute__((ext_vector_type(8)));
typedef unsigned u32x4 __attribute__((ext_vector_type(4)));
typedef unsigned u32x2 __attribute__((ext_vector_type(2)));
constexpr int D = 1024, NB = 16, SEQ = 2048, DEPTH = 4, CTXL = 256, NH = 16, FF = 2816;
constexpr int TL = NB * SEQ, TC = NB * CTXL, TT = TL + TC;
constexpr int NSET = 17, MODSET = 9 * D;
constexpr float LN_EPS = 1e-6f;
constexpr float DN_ALPHA = 1.681792830507429f;
constexpr int NWAVES = 8, NTHR = 512;
constexpr int LDS_BYTES = 147456;

constexpr size_t MiB = 1u << 20;
constexpr size_t WS_MOD = 1 * MiB;
constexpr size_t WS_STATS = 4 * MiB;
constexpr size_t WS_IDENT = 5 * MiB;
constexpr size_t WS_ROPE = 5 * MiB + 8192;
constexpr size_t WS_W1 = 6 * MiB;
constexpr size_t WS_W2 = WS_W1 + 88 * MiB;
constexpr size_t WS_WQK = WS_W2 + 44 * MiB;
constexpr size_t WS_WV = WS_WQK + 8 * MiB;
constexpr size_t WS_WO = WS_WV + 4 * MiB;
constexpr size_t WS_WC = WS_WO + 4 * MiB;
constexpr size_t WS_WCO = WS_WC + 12 * MiB;
constexpr size_t WS_Z = WS_WCO + 4 * MiB;
constexpr size_t WS_HB = WS_Z + 144 * MiB;
constexpr size_t WS_BIG = WS_HB + 72 * MiB;
constexpr size_t WS_END = WS_BIG + 216 * MiB;
static_assert(WS_W1 + (size_t)8 * 5632 * 1024 * 2 == WS_W2 && WS_Z + (size_t)TT * D * 4 == WS_HB && WS_HB + (size_t)TT * D * 2 == WS_BIG, "ws map");

__device__ __forceinline__ unsigned pk_bf16(float lo, float hi) { return pg8::cvt_pk_bf16(lo, hi); }
__device__ __forceinline__ float bf_lo(unsigned w) { return __uint_as_float(w << 16); }
__device__ __forceinline__ float bf_hi(unsigned w) { return __uint_as_float(w & 0xffff0000u); }
__device__ __forceinline__ float wave_sum(float v) {
#pragma unroll
    for (int o = 1; o < 64; o <<= 1) v += __shfl_xor(v, o);
    return v;
}

struct Args { const float* in[16]; float* out; unsigned char* ws; float inv_freq[16]; int ph_lo, ph_hi; };

__device__ __forceinline__ void transpose_item(const float* W, int K, int Nsrc, int srccol0, bf16* WT, int destrow0, int k0, LAS float* scr, int lane) {
    const int kr = lane >> 3, c4 = (lane & 7) * 4;
#pragma unroll
    for (int i = 0; i < 8; ++i) { const int k = kr + 8 * i; const f32x4 v = *(const f32x4*)(W + (size_t)(k0 + k) * Nsrc + srccol0 + c4);
        scr[k * 33 + c4 + 0] = v[0]; scr[k * 33 + c4 + 1] = v[1]; scr[k * 33 + c4 + 2] = v[2]; scr[k * 33 + c4 + 3] = v[3]; }
    asm volatile("s_waitcnt lgkmcnt(0)" ::: "memory");
    const int c = lane & 7;
#pragma unroll
    for (int j = 0; j < 4; ++j) { const int n = (lane >> 3) + 8 * j; const LAS float* s = scr + (8 * c) * 33 + n;
        u32x4 o; o.x = pk_bf16(s[0 * 33], s[1 * 33]); o.y = pk_bf16(s[2 * 33], s[3 * 33]); o.z = pk_bf16(s[4 * 33], s[5 * 33]); o.w = pk_bf16(s[6 * 33], s[7 * 33]);
        *(u32x4*)(WT + (size_t)(destrow0 + n) * K + k0 + 8 * c) = o; }
    asm volatile("s_waitcnt lgkmcnt(0)" ::: "memory");
}
constexpr int IT_W1 = 16 * 176, IT_W2 = 44 * 32, IT_QKV = 16 * 96, IT_SQ = 16 * 32, IT_WC = 16 * 96;
constexpr int SEG_A = 8 * IT_W1, SEG_B = SEG_A + 8 * IT_W2, SEG_C = SEG_B + 2 * IT_QKV, SEG_D = SEG_C + 2 * IT_SQ, SEG_E = SEG_D + 2 * IT_WC, SEG_F = SEG_E + 2 * IT_SQ;
__device__ __forceinline__ void transpose_dispatch(const Args& a, int it, LAS float* scr, int lane) {
    unsigned char* ws = a.ws;
    if (it < SEG_A) { const int mi = it / IT_W1, rem = it % IT_W1, kb = rem / 176, nb = rem % 176, n0 = 32 * nb, pn = n0 >> 8, w = n0 & 255;
        const int src = (w < 128) ? (128 * pn + w) : (FF + 128 * pn + (w - 128));
        transpose_item(a.in[8] + (size_t)mi * D * 2 * FF, D, 2 * FF, src, (bf16*)(ws + WS_W1) + (size_t)mi * 2 * FF * D, n0, 64 * kb, scr, lane); return; }
    if (it < SEG_B) { const int r = it - SEG_A, mi = r / IT_W2, rem = r % IT_W2, kb = rem / 32, nb = rem % 32;
        transpose_item(a.in[9] + (size_t)mi * FF * D, FF, D, 32 * nb, (bf16*)(ws + WS_W2) + (size_t)mi * D * FF, 32 * nb, 64 * kb, scr, lane); return; }
    if (it < SEG_C) { const int r = it - SEG_B, mi = r / IT_QKV, rem = r % IT_QKV, kb = rem / 96, nb = rem % 96, n0 = 32 * nb;
        if (n0 < 2048) transpose_item(a.in[10] + (size_t)mi * D * 3 * D, D, 3 * D, n0, (bf16*)(ws + WS_WQK) + (size_t)mi * 2048 * D, n0, 64 * kb, scr, lane);
        else transpose_item(a.in[10] + (size_t)mi * D * 3 * D, D, 3 * D, n0, (bf16*)(ws + WS_WV) + (size_t)mi * D * D, n0 - 2048, 64 * kb, scr, lane);
        return; }
    if (it < SEG_D) { const int r = it - SEG_C, mi = r / IT_SQ, rem = r % IT_SQ, kb = rem / 32, nb = rem % 32;
        transpose_item(a.in[11] + (size_t)mi * D * D, D, D, 32 * nb, (bf16*)(ws + WS_WO) + (size_t)mi * D * D, 32 * nb, 64 * kb, scr, lane); return; }
    if (it < SEG_E) { const int r = it - SEG_D, mi = r / IT_WC, rem = r % IT_WC, kb = rem / 96, nb = rem % 96, n0 = 32 * nb;
        int src; if (n0 < 2048) { const int pn = n0 >> 8, w = n0 & 255; src = (w < 128) ? (1024 + 128 * pn + w) : (2048 + 128 * pn + (w - 128)); } else src = n0 - 2048;
        transpose_item(a.in[13] + (size_t)mi * D * 3 * D, D, 3 * D, src, (bf16*)(ws + WS_WC) + (size_t)mi * 3 * D * D, n0, 64 * kb, scr, lane); return; }
    { const int r = it - SEG_E, mi = r / IT_SQ, rem = r % IT_SQ, kb = rem / 32, nb = rem % 32;
        transpose_item(a.in[15] + (size_t)mi * D * D, D, D, 32 * nb, (bf16*)(ws + WS_WCO) + (size_t)mi * D * D, 32 * nb, 64 * kb, scr, lane); }
}
__device__ __forceinline__ float silu_f(float v) { return v / (1.0f + __expf(-v)); }

__device__ __forceinline__ void phase0(const Args& a, LAS unsigned char* lds, int tid, int lane, int wave) {
    const int G = gridDim.x, bx = blockIdx.x;
    float* mod = (float*)(a.ws + WS_MOD);
    LAS float* sL = (LAS float*)lds;
    LAS float* red = (LAS float*)(lds + 81920);
    if (bx < 576) {
        for (int e = tid; e < NSET * D; e += NTHR) { const int s = e >> 10, k = e & 1023; const float v = (s < 16) ? a.in[1][s * D + k] : a.in[3][k]; sL[k * 20 + s] = silu_f(v); }
        __syncthreads();
        for (int unit = bx; unit < 576; unit += G) {
            const int i = unit / 144, col0 = (unit % 144) * 64;
            float acc[NSET];
#pragma unroll
            for (int s = 0; s < NSET; ++s) acc[s] = 0.f;
            const float* Wp = a.in[4] + (size_t)i * D * 9 * D + (size_t)(128 * wave) * 9 * D + col0 + lane;
#pragma unroll 8
            for (int kk = 0; kk < 128; ++kk) { const float wv = Wp[(size_t)kk * 9 * D]; const LAS float* sp = sL + (128 * wave + kk) * 20;
                const f32x4 s0 = *(const LAS f32x4*)sp, s1 = *(const LAS f32x4*)(sp + 4), s2 = *(const LAS f32x4*)(sp + 8), s3 = *(const LAS f32x4*)(sp + 12); const float s4 = sp[16];
                acc[0] += s0[0] * wv; acc[1] += s0[1] * wv; acc[2] += s0[2] * wv; acc[3] += s0[3] * wv;
                acc[4] += s1[0] * wv; acc[5] += s1[1] * wv; acc[6] += s1[2] * wv; acc[7] += s1[3] * wv;
                acc[8] += s2[0] * wv; acc[9] += s2[1] * wv; acc[10] += s2[2] * wv; acc[11] += s2[3] * wv;
                acc[12] += s3[0] * wv; acc[13] += s3[1] * wv; acc[14] += s3[2] * wv; acc[15] += s3[3] * wv; acc[16] += s4 * wv; }
#pragma unroll
            for (int s = 0; s < NSET; ++s) red[(wave * NSET + s) * 64 + lane] = acc[s];
            __syncthreads();
            for (int o = tid; o < NSET * 64; o += NTHR) { const int s = o >> 6, l = o & 63; float sum = 0.f;
#pragma unroll
                for (int w = 0; w < 8; ++w) sum += red[(w * NSET + s) * 64 + l];
                mod[((size_t)i * NSET + s) * MODSET + col0 + l] = sum + a.in[5][i * MODSET + col0 + l]; }
            __syncthreads();
        }
    }
    __syncthreads();
    LAS float* scr = (LAS float*)(lds + wave * 16384);
    const int gw = bx * NWAVES + wave, NGW = G * NWAVES;
    for (int it = gw; it < SEG_F; it += NGW) transpose_dispatch(a, it, scr, lane);
    if (bx == 0) {
        float* ident = (float*)(a.ws + WS_IDENT); float* rope = (float*)(a.ws + WS_ROPE);
        if (tid == 0) *(unsigned*)a.ws = 0u;
        for (int e = tid; e < 1024; e += NTHR) { ident[e] = 1.0f; ident[1024 + e] = 0.0f; }
        for (int e = tid; e < 1024; e += NTHR) { const int pos = e >> 4, f = e & 15; const float ang = (float)pos * a.inv_freq[f]; rope[e] = cosf(ang); rope[1024 + e] = sinf(ang); }
    }
}

__device__ __forceinline__ void ln_pass(const Args& a, int mode, int rows, const float* g, const float* b, const float* modl, int slot, int lane, int wave) {
    float* Z = (float*)(a.ws + WS_Z); float* stats = (float*)(a.ws + WS_STATS); bf16* Hb = (bf16*)(a.ws + WS_HB);
    const int gw = blockIdx.x * NWAVES + wave, NGW = gridDim.x * NWAVES;
    for (int row = gw; row < rows; row += NGW) {
        const float* zr = (mode == 0) ? ((row < TL) ? a.in[0] + (size_t)row * D : a.in[2] + (size_t)(row - TL) * D) : Z + (size_t)row * D;
        f32x4 v[4];
#pragma unroll
        for (int j = 0; j < 4; ++j) v[j] = ((const f32x4*)zr)[lane + 64 * j];
        if (mode == 0) {
#pragma unroll
            for (int j = 0; j < 4; ++j) ((f32x4*)(Z + (size_t)row * D))[lane + 64 * j] = v[j];
            if (lane == 0) *(f32x2*)(stats + 2 * (size_t)row) = (f32x2){0.f, 1.f};
        } else {
            float s = 0.f;
#pragma unroll
            for (int j = 0; j < 4; ++j) s += (v[j][0] + v[j][1]) + (v[j][2] + v[j][3]);
            const float mean = wave_sum(s) * (1.0f / D); float s2 = 0.f;
#pragma unroll
            for (int j = 0; j < 4; ++j) { v[j] = v[j] - mean; s2 += (v[j][0] * v[j][0] + v[j][1] * v[j][1]) + (v[j][2] * v[j][2] + v[j][3] * v[j][3]); }
            const float rstd = 1.0f / sqrtf(wave_sum(s2) * (1.0f / D) + LN_EPS);
            if (lane == 0) *(f32x2*)(stats + 2 * (size_t)row) = (f32x2){mean, rstd};
#pragma unroll
            for (int j = 0; j < 4; ++j) { const f32x4 gv = ((const f32x4*)g)[lane + 64 * j], bv = ((const f32x4*)b)[lane + 64 * j]; v[j] = v[j] * rstd * gv + bv; }
        }
        if (mode == 2) {
#pragma unroll
            for (int j = 0; j < 4; ++j) ((f32x4*)(a.out + (size_t)row * D))[lane + 64 * j] = v[j];
        } else {
            const int set = (row < TL) ? (row >> 11) : 16;
            const float* sh = modl + (size_t)set * MODSET + slot * D; const float* sc = sh + D;
#pragma unroll
            for (int j = 0; j < 4; ++j) { const f32x4 shv = ((const f32x4*)sh)[lane + 64 * j], scv = ((const f32x4*)sc)[lane + 64 * j];
                const f32x4 h = v[j] * (scv + 1.0f) + shv; u32x2 w; w.x = pk_bf16(h[0], h[1]); w.y = pk_bf16(h[2], h[3]);
                ((u32x2*)(Hb + (size_t)row * D))[lane + 64 * j] = w; }
        }
    }
}

__device__ __forceinline__ void attn_job(const bf16* Q, const bf16* K, const bf16* VT, bf16* O, const LAS float* rpbL, int b, int h, int qtok0, bool win, int r, int cb, int lane) {
    const int q = lane & 15, g = lane >> 4, hoff = h * 64, slot_off = 8 * (q >> 2) + (q & 3);
    const bf16* qp = Q + (size_t)(qtok0 + q) * D + hoff + 8 * g;
    const bf16x8 qf0 = *(const bf16x8*)qp, qf1 = *(const bf16x8*)(qp + 32);
    const int rs = min(max(r - 4, 0), 24), blk_c0 = min(max(16 * cb - 8, 0), 32);
    const int wtok0 = b * SEQ + rs * 64 + blk_c0, ctok0 = TL + b * CTXL;
    const float NEG = -1.0e30f, L2E = 1.44269504089f;
    const bf16* vbase = VT + (size_t)(hoff + q) * TT + 8 * g;
    f32x4 oacc[4];
#pragma unroll
    for (int dt = 0; dt < 4; ++dt) oacc[dt] = (f32x4){0.f, 0.f, 0.f, 0.f};
    float mx = NEG, sum = 0.f;
    f32x4 sc[8][2];
    if (win) {
#pragma unroll
        for (int i = 0; i < 8; ++i)
#pragma unroll
            for (int t = 0; t < 2; ++t) { const bf16* kp = K + (size_t)(wtok0 + 64 * i + slot_off + 4 * t) * D + hoff + 8 * g;
                const bf16x8 k0 = *(const bf16x8*)kp, k1 = *(const bf16x8*)(kp + 32);
                f32x4 acc = (f32x4){0.f, 0.f, 0.f, 0.f};
                acc = __builtin_amdgcn_mfma_f32_16x16x32_bf16(k0, qf0, acc, 0, 0, 0); acc = __builtin_amdgcn_mfma_f32_16x16x32_bf16(k1, qf1, acc, 0, 0, 0); sc[i][t] = acc; }
        const int qc = 16 * cb + q, win_c0 = min(max(qc - 8, 0), 48);
#pragma unroll
        for (int i = 0; i < 8; ++i) { const int dyo = (rs + i - r + 7) * 31;
#pragma unroll
            for (int t = 0; t < 2; ++t)
#pragma unroll
                for (int j = 0; j < 4; ++j) { const int kc = blk_c0 + 8 * g + 4 * t + j; const bool ok = (kc >= win_c0) && (kc < win_c0 + 16);
                    const int idx = ok ? (dyo + kc - qc + 15) : 0; const float bias = rpbL[idx];
                    const float s = ok ? (sc[i][t][j] + bias) : NEG; sc[i][t][j] = s; mx = fmaxf(mx, s); } }
        mx = fmaxf(mx, __shfl_xor(mx, 16)); mx = fmaxf(mx, __shfl_xor(mx, 32));
        const float mo = mx * L2E;
#pragma unroll
        for (int i = 0; i < 8; ++i) {
#pragma unroll
            for (int t = 0; t < 2; ++t)
#pragma unroll
                for (int j = 0; j < 4; ++j) { const float p = __builtin_amdgcn_exp2f(sc[i][t][j] * L2E - mo); sc[i][t][j] = p; sum += p; }
            u32x4 pw; pw.x = pg8::cvt_pk_bf16_safe(sc[i][0][0], sc[i][0][1]); pw.y = pg8::cvt_pk_bf16_safe(sc[i][0][2], sc[i][0][3]); pw.z = pg8::cvt_pk_bf16_safe(sc[i][1][0], sc[i][1][1]); pw.w = pg8::cvt_pk_bf16_safe(sc[i][1][2], sc[i][1][3]);
            const bf16x8 pf = __builtin_bit_cast(bf16x8, pw);
#pragma unroll
            for (int dt = 0; dt < 4; ++dt) { const bf16x8 vf = *(const bf16x8*)(vbase + (size_t)(16 * dt) * TT + wtok0 + 64 * i);
                oacc[dt] = __builtin_amdgcn_mfma_f32_16x16x32_bf16(vf, pf, oacc[dt], 0, 0, 0); } }
    }
#pragma unroll
    for (int i = 0; i < 8; ++i)
#pragma unroll
        for (int t = 0; t < 2; ++t) { const bf16* kp = K + (size_t)(ctok0 + 32 * i + slot_off + 4 * t) * D + hoff + 8 * g;
            const bf16x8 k0 = *(const bf16x8*)kp, k1 = *(const bf16x8*)(kp + 32);
            f32x4 acc = (f32x4){0.f, 0.f, 0.f, 0.f};
            acc = __builtin_amdgcn_mfma_f32_16x16x32_bf16(k0, qf0, acc, 0, 0, 0); acc = __builtin_amdgcn_mfma_f32_16x16x32_bf16(k1, qf1, acc, 0, 0, 0); sc[i][t] = acc; }
    float m2 = mx;
#pragma unroll
    for (int i = 0; i < 8; ++i)
#pragma unroll
        for (int t = 0; t < 2; ++t)
#pragma unroll
            for (int j = 0; j < 4; ++j) m2 = fmaxf(m2, sc[i][t][j]);
    m2 = fmaxf(m2, __shfl_xor(m2, 16)); m2 = fmaxf(m2, __shfl_xor(m2, 32));
    const float resc = __builtin_amdgcn_exp2f((mx - m2) * L2E), mo2 = m2 * L2E;
    sum *= resc;
#pragma unroll
    for (int dt = 0; dt < 4; ++dt) oacc[dt] = oacc[dt] * resc;
#pragma unroll
    for (int i = 0; i < 8; ++i) {
#pragma unroll
        for (int t = 0; t < 2; ++t)
#pragma unroll
            for (int j = 0; j < 4; ++j) { const float p = __builtin_amdgcn_exp2f(sc[i][t][j] * L2E - mo2); sc[i][t][j] = p; sum += p; }
        u32x4 pw; pw.x = pg8::cvt_pk_bf16_safe(sc[i][0][0], sc[i][0][1]); pw.y = pg8::cvt_pk_bf16_safe(sc[i][0][2], sc[i][0][3]); pw.z = pg8::cvt_pk_bf16_safe(sc[i][1][0], sc[i][1][1]); pw.w = pg8::cvt_pk_bf16_safe(sc[i][1][2], sc[i][1][3]);
        const bf16x8 pf = __builtin_bit_cast(bf16x8, pw);
#pragma unroll
        for (int dt = 0; dt < 4; ++dt) { const bf16x8 vf = *(const bf16x8*)(vbase + (size_t)(16 * dt) * TT + ctok0 + 32 * i);
            oacc[dt] = __builtin_amdgcn_mfma_f32_16x16x32_bf16(vf, pf, oacc[dt], 0, 0, 0); } }
    sum += __shfl_xor(sum, 16); sum += __shfl_xor(sum, 32);
    const float inv = 1.0f / sum;
    bf16* op = O + (size_t)(qtok0 + q) * D + hoff + 4 * g;
#pragma unroll
    for (int dt = 0; dt < 4; ++dt) { u32x2 w; w.x = pg8::cvt_pk_bf16_safe(oacc[dt][0] * inv, oacc[dt][1] * inv); w.y = pg8::cvt_pk_bf16_safe(oacc[dt][2] * inv, oacc[dt][3] * inv); *(u32x2*)(op + 16 * dt) = w; }
}
__device__ __forceinline__ void attn_phase(const Args& a, LAS unsigned char* lds, const float* rpb, bool ctxq, int tid, int lane, int wave) {
    const bf16* Q = (const bf16*)(a.ws + WS_BIG); const bf16* K = Q + (size_t)TT * D; const bf16* VT = K + (size_t)TT * D; bf16* O = (bf16*)(a.ws + WS_HB);
    LAS float* rpbL = (LAS float*)lds;
    const int njobs = 128 + (ctxq ? 16 : 0);
    for (int bh = blockIdx.x; bh < NB * NH; bh += gridDim.x) {
        const int b = bh >> 4, h = bh & 15;
        __syncthreads();
        for (int e = tid; e < 465; e += NTHR) rpbL[e] = rpb[h * 465 + e];
        __syncthreads();
        for (int jj = wave; jj < njobs; jj += NWAVES) {
            if (jj < 128) attn_job(Q, K, VT, O, rpbL, b, h, b * SEQ + (jj >> 2) * 64 + (jj & 3) * 16, true, jj >> 2, jj & 3, lane);
            else attn_job(Q, K, VT, O, rpbL, b, h, TL + b * CTXL + (jj - 128) * 16, false, 0, 0, lane);
        }
    }
}

__device__ __forceinline__ void conv_phase(const Args& a, const float* cw, int rows, int tid) {
    const bf16* U = (const bf16*)(a.ws + WS_BIG); const bf16* Bg = U + (size_t)TT * D; bf16* Gm = (bf16*)(a.ws + WS_HB);
    const long total = (long)rows * 128, nthr = (long)gridDim.x * NTHR;
    for (long item = (long)blockIdx.x * NTHR + tid; item < total; item += nthr) {
        const int t = (int)(item >> 7), d0 = ((int)item & 127) * 8;
        int p, L; if (t < TL) { p = t & (SEQ - 1); L = SEQ; } else { p = (t - TL) & (CTXL - 1); L = CTXL; }
        const u32x4 z4 = (u32x4){0u, 0u, 0u, 0u};
        const u32x4 uc = *(const u32x4*)(U + (size_t)t * D + d0), bg = *(const u32x4*)(Bg + (size_t)t * D + d0);
        const u32x4 up = (p > 0) ? *(const u32x4*)(U + (size_t)(t - 1) * D + d0) : z4;
        const u32x4 un = (p < L - 1) ? *(const u32x4*)(U + (size_t)(t + 1) * D + d0) : z4;
        const f32x4 w0a = *(const f32x4*)(cw + d0), w0b = *(const f32x4*)(cw + d0 + 4), w1a = *(const f32x4*)(cw + D + d0), w1b = *(const f32x4*)(cw + D + d0 + 4),
                    w2a = *(const f32x4*)(cw + 2 * D + d0), w2b = *(const f32x4*)(cw + 2 * D + d0 + 4);
        u32x4 o;
#define CONV2(k, wA, wB, ia, ib) (pk_bf16(bf_lo(bg[k]) * (wA##0[ia] * bf_lo(up[k]) + wA##1[ia] * bf_lo(uc[k]) + wA##2[ia] * bf_lo(un[k])), bf_hi(bg[k]) * (wB##0[ib] * bf_hi(up[k]) + wB##1[ib] * bf_hi(uc[k]) + wB##2[ib] * bf_hi(un[k]))))
        o.x = pk_bf16(bf_lo(bg.x) * (w0a[0] * bf_lo(up.x) + w1a[0] * bf_lo(uc.x) + w2a[0] * bf_lo(un.x)), bf_hi(bg.x) * (w0a[1] * bf_hi(up.x) + w1a[1] * bf_hi(uc.x) + w2a[1] * bf_hi(un.x)));
        o.y = pk_bf16(bf_lo(bg.y) * (w0a[2] * bf_lo(up.y) + w1a[2] * bf_lo(uc.y) + w2a[2] * bf_lo(un.y)), bf_hi(bg.y) * (w0a[3] * bf_hi(up.y) + w1a[3] * bf_hi(uc.y) + w2a[3] * bf_hi(un.y)));
        o.z = pk_bf16(bf_lo(bg.z) * (w0b[0] * bf_lo(up.z) + w1b[0] * bf_lo(uc.z) + w2b[0] * bf_lo(un.z)), bf_hi(bg.z) * (w0b[1] * bf_hi(up.z) + w1b[1] * bf_hi(uc.z) + w2b[1] * bf_hi(un.z)));
        o.w = pk_bf16(bf_lo(bg.w) * (w0b[2] * bf_lo(up.w) + w1b[2] * bf_lo(uc.w) + w2b[2] * bf_lo(un.w)), bf_hi(bg.w) * (w0b[3] * bf_hi(up.w) + w1b[3] * bf_hi(uc.w) + w2b[3] * bf_hi(un.w)));
#undef CONV2
        *(u32x4*)(Gm + (size_t)t * D + d0) = o;
    }
}

#ifndef DBG_CHECK
#define DBG_CHECK 0
#endif
__device__ __forceinline__ unsigned hash_u(unsigned x) { x ^= x >> 16; x *= 0x7feb352dU; x ^= x >> 15; x *= 0x846ca68bU; x ^= x >> 16; return x; }
__device__ __forceinline__ float bfr(float f) { unsigned u = __float_as_uint(f); u = (u + 0x7fffu + ((u >> 16) & 1u)) & 0xffff0000u; return __uint_as_float(u); }
__device__ __forceinline__ float bf2f(bf16 v) { return __uint_as_float((unsigned)v << 16); }
__device__ __forceinline__ void flag_if(bool badv, unsigned* flags, unsigned bit) { if (badv) atomicOr(flags, bit); }
#define CHK_LOOP(n) for (unsigned sidx = blockIdx.x * NTHR + threadIdx.x; sidx < (n); sidx += gridDim.x * NTHR)
__device__ __forceinline__ void chk_mod(const Args& a, unsigned* flags) {
    const float* mod = (const float*)(a.ws + WS_MOD);
    CHK_LOOP(4096u) { const unsigned h = hash_u(sidx * 3u + 1u); const int i = h & 3, s = (h >> 2) % 17, col = (h >> 8) % 9216;
        float acc = 0.f;
        for (int k = 0; k < D; ++k) { const float c = (s < 16) ? a.in[1][s * D + k] : a.in[3][k]; acc += (c / (1.0f + expf(-c))) * a.in[4][((size_t)i * D + k) * 9 * D + col]; }
        acc += a.in[5][i * 9 * D + col];
        const float got = mod[((size_t)i * NSET + s) * MODSET + col];
        flag_if(!(fabsf(got - acc) <= 2e-3f * fabsf(acc) + 2e-3f), flags, 1u); }
}
__device__ __forceinline__ void chk_gemm1(const Args& a, unsigned* flags) {
    const bf16* Hb = (const bf16*)(a.ws + WS_HB); const bf16* hid = (const bf16*)(a.ws + WS_BIG);
    CHK_LOOP(4096u) { const unsigned h = hash_u(sidx * 5u + 2u); const int row = h % TT, hc = (h >> 16) % FF;
        float av = 0.f, uv = 0.f;
        for (int k = 0; k < D; ++k) { const float x = bf2f(Hb[(size_t)row * D + k]); av += x * bfr(a.in[8][(size_t)k * 2 * FF + hc]); uv += x * bfr(a.in[8][(size_t)k * 2 * FF + FF + hc]); }
        const float ref = av / (1.0f + expf(-av)) * uv, got = bf2f(hid[(size_t)row * FF + hc]);
        flag_if(!(fabsf(got - ref) <= 0.02f * fabsf(ref) + 0.02f), flags, 2u); }
}
__device__ __forceinline__ void chk_res0(const Args& a, unsigned* flags) {
    const bf16* hid = (const bf16*)(a.ws + WS_BIG); const float* Z = (const float*)(a.ws + WS_Z); const float* mod = (const float*)(a.ws + WS_MOD);
    CHK_LOOP(4096u) { const unsigned h = hash_u(sidx * 7u + 3u); const int row = h % TT, col = (h >> 16) % D;
        float y = 0.f;
        for (int k = 0; k < FF; ++k) y += bf2f(hid[(size_t)row * FF + k]) * bfr(a.in[9][(size_t)k * D + col]);
        const float xin = (row < TL) ? a.in[0][(size_t)row * D + col] : a.in[2][(size_t)(row - TL) * D + col];
        const int set = (row < TL) ? (row >> 11) : 16;
        const float ref = DN_ALPHA * xin + 0.5f * mod[(size_t)set * MODSET + 2 * D + col] * y, got = Z[(size_t)row * D + col];
        flag_if(!(fabsf(got - ref) <= 5e-3f * fabsf(ref) + 5e-3f), flags, 4u); }
}
__device__ __forceinline__ void chk_ln(const Args& a, unsigned* flags) {
    const bf16* Hb = (const bf16*)(a.ws + WS_HB); const float* Z = (const float*)(a.ws + WS_Z); const float* mod = (const float*)(a.ws + WS_MOD);
    CHK_LOOP(1024u) { const unsigned h = hash_u(sidx * 11u + 4u); const int row = h % TT, col = (h >> 16) % D;
        float s = 0.f; for (int k = 0; k < D; ++k) s += Z[(size_t)row * D + k];
        const float mean = s / D; float q = 0.f; for (int k = 0; k < D; ++k) { const float d = Z[(size_t)row * D + k] - mean; q += d * d; }
        const float rstd = 1.0f / sqrtf(q / D + LN_EPS);
        const float x = (Z[(size_t)row * D + col] - mean) * rstd * a.in[6][col] + a.in[7][col];
        const int set = (row < TL) ? (row >> 11) : 16;
        const float ref = x * (1.0f + mod[(size_t)set * MODSET + 4 * D + col]) + mod[(size_t)set * MODSET + 3 * D + col], got = bf2f(Hb[(size_t)row * D + col]);
        flag_if(!(fabsf(got - ref) <= 0.01f * fabsf(ref) + 0.01f), flags, 8u); }
}
__device__ __forceinline__ float chk_dot(const Args& a, const bf16* Hb, int row, int col) { float v = 0.f; for (int k = 0; k < D; ++k) v += bf2f(Hb[(size_t)row * D + k]) * bfr(a.in[10][(size_t)k * 3 * D + col]); return v; }
__device__ __forceinline__ void chk_qkv(const Args& a, unsigned* flags) {
    const bf16* Hb = (const bf16*)(a.ws + WS_HB); const bf16* Q = (const bf16*)(a.ws + WS_BIG); const bf16* K = Q + (size_t)TT * D; const bf16* VT = K + (size_t)TT * D;
    CHK_LOOP(4096u) { const unsigned h = hash_u(sidx * 13u + 5u); const int row = h % TT, which = (h >> 16) % 3, head = (h >> 18) & 15, d = (h >> 22) & 63;
        float ref, got;
        if (which == 2) { ref = chk_dot(a, Hb, row, 2 * D + head * 64 + d); got = bf2f(VT[(size_t)(head * 64 + d) * TT + row]); }
        else { const int half = d >> 5, dd = d & 31, f = dd & 15; const bool x1 = dd < 16; const int d1 = half * 32 + f, d2 = d1 + 16;
            const float v1 = chk_dot(a, Hb, row, which * D + head * 64 + d1), v2 = chk_dot(a, Hb, row, which * D + head * 64 + d2);
            float c = 1.f, s = 0.f; if (row < TL) { const int t = row & 2047, pos = half ? (t & 63) : (t >> 6); const float ang = (float)pos * a.inv_freq[f]; c = cosf(ang); s = sinf(ang); }
            ref = x1 ? (v1 * c - v2 * s) : (v2 * c + v1 * s); if (which == 0) ref *= 0.125f;
            got = bf2f((which == 0 ? Q : K)[(size_t)row * D + head * 64 + d]); }
        flag_if(!(fabsf(got - ref) <= 0.02f * fabsf(ref) + 0.02f), flags, 16u); }
}
__device__ __forceinline__ void chk_attn(const Args& a, unsigned* flags) {
    const bf16* O = (const bf16*)(a.ws + WS_HB); const bf16* Q = (const bf16*)(a.ws + WS_BIG); const bf16* K = Q + (size_t)TT * D; const bf16* VT = K + (size_t)TT * D;
    CHK_LOOP(4096u) { const unsigned h = hash_u(sidx * 17u + 6u); const int row = h % TT, head = (h >> 16) & 15, d = (h >> 20) & 63;
        const bf16* qp = Q + (size_t)row * D + head * 64; const bf16* vrow = VT + (size_t)(head * 64 + d) * TT;
        float m = -1e30f, l = 0.f, o = 0.f; int b;
        if (row < TL) { b = row >> 11; const int t = row & 2047, r = t >> 6, qc = t & 63, rs = min(max(r - 4, 0), 24), w0 = min(max(qc - 8, 0), 48);
            for (int i = 0; i < 8; ++i) for (int kc = w0; kc < w0 + 16; ++kc) { const int kt = b * SEQ + (rs + i) * 64 + kc; const bf16* kp = K + (size_t)kt * D + head * 64;
                float s = 0.f; for (int e = 0; e < 64; ++e) s += bf2f(qp[e]) * bf2f(kp[e]);
                s += a.in[12][(size_t)head * 465 + (rs + i - r + 7) * 31 + (kc - qc + 15)];
                const float mn = fmaxf(m, s), sc = expf(m - mn), p = expf(s - mn); l = l * sc + p; o = o * sc + p * bf2f(vrow[kt]); m = mn; } }
        else b = (row - TL) >> 8;
        for (int c = 0; c < CTXL; ++c) { const int kt = TL + b * CTXL + c; const bf16* kp = K + (size_t)kt * D + head * 64;
            float s = 0.f; for (int e = 0; e < 64; ++e) s += bf2f(qp[e]) * bf2f(kp[e]);
            const float mn = fmaxf(m, s), sc = expf(m - mn), p = expf(s - mn); l = l * sc + p; o = o * sc + p * bf2f(vrow[kt]); m = mn; }
        const float ref = o / l, got = bf2f(O[(size_t)row * D + head * 64 + d]);
        flag_if(!(fabsf(got - ref) <= 0.03f * fabsf(ref) + 0.004f), flags, 32u); }
}

__global__ void __launch_bounds__(NTHR, 2) mega_fwd(Args args) {
    extern __shared__ __attribute__((aligned(16))) unsigned char lds_raw[];
    LAS unsigned char* lds = (LAS unsigned char*)lds_raw;
    cg::grid_group grid = cg::this_grid();
    const int tid = threadIdx.x, lane = tid & 63, wave = __builtin_amdgcn_readfirstlane(tid >> 6);
    const int G = gridDim.x, bx = blockIdx.x;
    unsigned char* ws = args.ws;
    const float* mod = (const float*)(ws + WS_MOD);
    float* Z = (float*)(ws + WS_Z); const float* stats = (const float*)(ws + WS_STATS);
    const float* ident = (const float*)(ws + WS_IDENT);
    bf16* Hb = (bf16*)(ws + WS_HB); bf16* BIG = (bf16*)(ws + WS_BIG);
    const float* ln_g = args.in[6]; const float* ln_b = args.in[7];
    const int lo = args.ph_lo, hi = args.ph_hi;
    int step = 0;
#define GRID_SYNC() do { asm volatile("s_waitcnt vmcnt(0)" ::: "memory"); __syncthreads(); \
    if (threadIdx.x < 64) { __builtin_amdgcn_fence(__ATOMIC_RELEASE, "agent"); asm volatile("s_waitcnt vmcnt(0)" ::: "memory"); } \
    grid.sync(); \
    if (threadIdx.x < 64) { __builtin_amdgcn_fence(__ATOMIC_ACQUIRE, "agent"); asm volatile("s_waitcnt vmcnt(0)" ::: "memory"); } __syncthreads(); } while (0)
#ifndef KEEPMASK
#define KEEPMASK 0xffffffffu
#endif
#define RUN(id, ...) do { if constexpr ((KEEPMASK >> (id)) & 1u) { if (step >= lo && step < hi) { { int tid = threadIdx.x; asm volatile("" : "+v"(tid)); const int lane = tid & 63, wave = __builtin_amdgcn_readfirstlane(tid >> 6); (void)lane; (void)wave; __VA_ARGS__; } if (step + 1 < hi) { GRID_SYNC(); } } } ++step; } while (0)

    RUN(0, phase0(args, lds, tid, lane, wave));
#if (DBG_CHECK & 1)
    RUN(16, chk_mod(args, (unsigned*)ws));
#endif
    RUN(1, ln_pass(args, 0, TT, ident, ident + 1024, mod, 0, lane, wave));
    const float* pg = ident; const float* pb = ident + 1024;
#pragma nounroll
    for (int i = 0; i < DEPTH; ++i) {
        const float* modl = mod + (size_t)i * NSET * MODSET;
        const int jl = i >> 1;
        const int M1 = (i <= 2) ? TT : TL;
        const int Mm = (i <= 1) ? TT : TL;
        const int M2 = (i <= 1) ? TT : TL;
        RUN(2, { pg8::Gemm g{Hb, (const bf16*)(ws + WS_W1) + (size_t)(2 * i) * 2 * FF * D, M1, 2 * FF, D}; pg8::StaticOrder S; S.init(M1, 2 * FF, G, bx);
              pg8::EpiSwiglu E{BIG, FF}; pg8::gemm_phase<pg8::EpiSwiglu, pg8::StaticOrder, true, true>(lds, g, S, E, tid); });
#if (DBG_CHECK & 2)
        if (i == 0) RUN(17, chk_gemm1(args, (unsigned*)ws)); else ++step;
#endif
        RUN(3, { pg8::Gemm g{BIG, (const bf16*)(ws + WS_W2) + (size_t)(2 * i) * D * FF, M1, D, FF}; pg8::StaticOrder S; S.init(M1, D, G, bx);
              pg8::EpiRes E{Z, stats, pg, pb, modl + 2 * D, 0.5f, DN_ALPHA}; pg8::gemm_phase<pg8::EpiRes, pg8::StaticOrder, true, true>(lds, g, S, E, tid); });
#if (DBG_CHECK & 4)
        if (i == 0) RUN(18, chk_res0(args, (unsigned*)ws)); else ++step;
#endif
        pg = ln_g + (size_t)(i * 3 + 0) * D; pb = ln_b + (size_t)(i * 3 + 0) * D;
        RUN(4, ln_pass(args, 1, (i == 2) ? TT : Mm, pg, pb, modl, 3, lane, wave));
#if (DBG_CHECK & 8)
        if (i == 0) RUN(19, chk_ln(args, (unsigned*)ws)); else ++step;
#endif
        if ((i & 1) == 0) {
            RUN(5, { { pg8::Gemm g{Hb, (const bf16*)(ws + WS_WQK) + (size_t)jl * 2048 * D, TT, 2048, D}; pg8::StaticOrder S; S.init(TT, 2048, G, bx);
                    pg8::EpiQK E{BIG, BIG + (size_t)TT * D, (const float*)(ws + WS_ROPE), (const float*)(ws + WS_ROPE) + 1024};
                    pg8::gemm_phase<pg8::EpiQK, pg8::StaticOrder, true, true>(lds, g, S, E, tid); }
                  { pg8::Gemm g{(const bf16*)(ws + WS_WV) + (size_t)jl * D * D, Hb, D, TT, D}; pg8::StaticOrder S; S.init(D, TT, G, bx);
                    pg8::EpiStoreBf16 E{BIG + (size_t)2 * TT * D, TT};
                    pg8::gemm_phase<pg8::EpiStoreBf16, pg8::StaticOrder, true, true>(lds, g, S, E, tid); } });
#if (DBG_CHECK & 16)
            if (i == 0) RUN(20, chk_qkv(args, (unsigned*)ws)); else ++step;
#endif
            RUN(6, attn_phase(args, lds, args.in[12] + (size_t)jl * NH * 465, i == 0, tid, lane, wave));
#if (DBG_CHECK & 32)
            if (i == 0) RUN(21, chk_attn(args, (unsigned*)ws)); else ++step;
#endif
            RUN(7, { pg8::Gemm g{Hb, (const bf16*)(ws + WS_WO) + (size_t)jl * D * D, Mm, D, D}; pg8::StaticOrder S; S.init(Mm, D, G, bx);
                  pg8::EpiRes E{Z, stats, pg, pb, modl + 5 * D, 1.0f, DN_ALPHA}; pg8::gemm_phase<pg8::EpiRes, pg8::StaticOrder, true, true>(lds, g, S, E, tid); });
        } else {
            RUN(8, { pg8::Gemm g{Hb, (const bf16*)(ws + WS_WC) + (size_t)jl * 3 * D * D, Mm, 3 * D, D}; pg8::StaticOrder S; S.init(Mm, 3 * D, G, bx);
                  pg8::EpiConvIn E{BIG, BIG + (size_t)TT * D}; pg8::gemm_phase<pg8::EpiConvIn, pg8::StaticOrder, true, true>(lds, g, S, E, tid); });
            RUN(9, conv_phase(args, args.in[14] + (size_t)jl * 3 * D, Mm, tid));
            RUN(10, { pg8::Gemm g{Hb, (const bf16*)(ws + WS_WCO) + (size_t)jl * D * D, Mm, D, D}; pg8::StaticOrder S; S.init(Mm, D, G, bx);
                  pg8::EpiRes E{Z, stats, pg, pb, modl + 5 * D, 1.0f, DN_ALPHA}; pg8::gemm_phase<pg8::EpiRes, pg8::StaticOrder, true, true>(lds, g, S, E, tid); });
        }
        pg = ln_g + (size_t)(i * 3 + 1) * D; pb = ln_b + (size_t)(i * 3 + 1) * D;
        RUN(11, ln_pass(args, 1, M2, pg, pb, modl, 6, lane, wave));
        RUN(12, { pg8::Gemm g{Hb, (const bf16*)(ws + WS_W1) + (size_t)(2 * i + 1) * 2 * FF * D, M2, 2 * FF, D}; pg8::StaticOrder S; S.init(M2, 2 * FF, G, bx);
              pg8::EpiSwiglu E{BIG, FF}; pg8::gemm_phase<pg8::EpiSwiglu, pg8::StaticOrder, true, true>(lds, g, S, E, tid); });
        RUN(13, { pg8::Gemm g{BIG, (const bf16*)(ws + WS_W2) + (size_t)(2 * i + 1) * D * FF, M2, D, FF}; pg8::StaticOrder S; S.init(M2, D, G, bx);
              pg8::EpiRes E{Z, stats, pg, pb, modl + 8 * D, 0.5f, DN_ALPHA}; pg8::gemm_phase<pg8::EpiRes, pg8::StaticOrder, true, true>(lds, g, S, E, tid); });
        pg = ln_g + (size_t)(i * 3 + 2) * D; pb = ln_b + (size_t)(i * 3 + 2) * D;
        if (i < DEPTH - 1) { const int Mn = (i + 1 <= 2) ? TT : TL; RUN(14, ln_pass(args, 1, Mn, pg, pb, mod + (size_t)(i + 1) * NSET * MODSET, 0, lane, wave)); }
        else RUN(15, ln_pass(args, 2, TL, pg, pb, modl, 0, lane, wave));
    }
#if DBG_CHECK
    if (blockIdx.x == 0 && threadIdx.x == 0) { const unsigned mask = __hip_atomic_load((unsigned*)ws, __ATOMIC_RELAXED, __HIP_MEMORY_SCOPE_AGENT); if (mask) args.out[0] = 1000.0f + 100.0f * (float)mask; }
#endif
#undef RUN
}

extern "C" void kernel_launch(void* const* d_in, const int* in_sizes, int n_in, void* d_out, int out_size, void* d_ws, size_t ws_size, hipStream_t stream) {
    static int grid = 0;
    if (grid == 0) {
        if (n_in != 16 || ws_size < WS_END) { fprintf(stderr, "kernel_launch: need 16 inputs and >= %zu bytes of workspace (got %d, %zu)\n", (size_t)WS_END, n_in, ws_size); grid = -1; return; }
        int dev = 0, cus = 0, per_cu = 0;
        hipGetDevice(&dev); hipDeviceGetAttribute(&cus, hipDeviceAttributeMultiprocessorCount, dev);
        if (hipFuncSetAttribute((const void*)mega_fwd, hipFuncAttributeMaxDynamicSharedMemorySize, LDS_BYTES) != hipSuccess) { fprintf(stderr, "kernel_launch: hipFuncSetAttribute failed\n"); grid = -1; return; }
        if (hipOccupancyMaxActiveBlocksPerMultiprocessor(&per_cu, (const void*)mega_fwd, NTHR, LDS_BYTES) != hipSuccess || per_cu < 1) { fprintf(stderr, "kernel_launch: occupancy query gave %d\n", per_cu); per_cu = 1; }
        (void)hipGetLastError();
        grid = cus * per_cu;
        fprintf(stderr, "kernel_launch: grid %d (cus %d x %d)\n", grid, cus, per_cu);
    }
    if (grid < 0) return;
    Args a{};
    for (int i = 0; i < 16; ++i) a.in[i] = (const float*)d_in[i];
    a.out = (float*)d_out; a.ws = (unsigned char*)d_ws;
    for (int f = 0; f < 16; ++f) a.inv_freq[f] = (float)pow(10000.0, -(double)f / 16.0);
    a.ph_lo = 0; a.ph_hi = 1 << 20;
    void* kargs[] = {&a};
    hipError_t e = hipLaunchCooperativeKernel((const void*)mega_fwd, dim3(grid), dim3(NTHR), kargs, LDS_BYTES, stream);
    if (e != hipSuccess) fprintf(stderr, "kernel_launch: cooperative launch failed: %s (grid %d)\n", hipGetErrorString(e), grid);
}
```

```cpp
#include <hip/hip_runtime.h>
#include <hip/hip_cooperative_groups.h>
#include <cstdio>
#include <cstdint>
#include <cmath>
namespace cg = cooperative_groups;
namespace pg8 {
#define PG8_LAS __attribute__((address_space(3)))
typedef unsigned short bf16_t;
typedef short bf16x8 __attribute__((ext_vector_type(8)));
typedef float f32x4 __attribute__((ext_vector_type(4)));
typedef unsigned u32x4 __attribute__((ext_vector_type(4)));
constexpr int BM = 256, BK = 64, HALF = 128, HTB = HALF * BK * 2  , STAGE_BYTES = 8 * HTB, NXCD = 8, WGM = 8;

__host__ __device__ __forceinline__ int lds_byte(int r, int c) { const int st = (r >> 4) * 2 + (c >> 5), rr = r & 15, cc = c & 31, ob = rr * 64 + cc * 2; return st * 1024 + (ob ^ (((ob >> 9) & 1) << 5)); }
__host__ __device__ __forceinline__ void stage_rc(int b, int& R, int& C) { const int st = b / 1024, sb = b % 1024, swz = sb ^ (((sb >> 9) & 1) << 5); R = (st >> 1) * 16 + swz / 64; C = (st & 1) * 32 + (swz % 64) / 2; }
__host__ __device__ __forceinline__ int perm32(int rho) { const int n = rho >> 4, i = rho & 15; return 8 * (i >> 2) + 4 * n + (i & 3); }

struct Unit { int pm, pn; };
struct Gemm { const bf16_t* A; const bf16_t* Bt; int M, N, K; };

struct StaticOrder {
    int nM, nN, nwg, G, c;
    __host__ __device__ void init(int M, int N, int G_, int c_) { nM = M / BM; nN = N / BM; nwg = nM * nN; G = G_; c = c_; }
    __host__ __device__ bool next(int i, Unit& u) const {
        const long L = (long)i * G + c; if (L >= nwg) return false;
        int wgid = (int)L; { const int q = nwg / NXCD, r = nwg % NXCD, xcd = wgid % NXCD, off = wgid / NXCD; wgid = (xcd < r ? xcd * (q + 1) : r * (q + 1) + (xcd - r) * q) + off; }
        const int nig = WGM * nN, gid = wgid / nig, fm = gid * WGM, gsz = (nM - fm) < WGM ? (nM - fm) : WGM;
        u.pm = fm + ((wgid % nig) % gsz); u.pn = (wgid % nig) / gsz; return true;
    }
    __device__ __forceinline__ void a_ready(const Unit&) const {}
    __device__ __forceinline__ void done(const Unit&) const {}
};

__device__ __forceinline__ unsigned cvt_pk_bf16(float lo, float hi) { unsigned r; asm volatile("v_cvt_pk_bf16_f32 %0, %1, %2" : "=v"(r) : "v"(lo), "v"(hi)); return r; }
__device__ __forceinline__ unsigned cvt_pk_bf16_safe(float lo, float hi) { unsigned r; asm volatile("s_nop 1\n\tv_cvt_pk_bf16_f32 %0, %1, %2\n\ts_nop 1" : "=v"(r) : "v"(lo), "v"(hi)); return r; }
typedef float f32x2 __attribute__((ext_vector_type(2)));
typedef unsigned u32x2 __attribute__((ext_vector_type(2)));
constexpr int EP_TL = 32768;
constexpr int EP_MODSET = 9 * 1024;

struct EpiStoreBf16 {
    static constexpr bool PERM = true, AFTER_DRAIN = false;
    bf16_t* O; int ldc;
    __device__ __forceinline__ void operator()(const f32x4 (&acc)[2][2][4][2], const Unit& u, int wr, int wc, int fr, int fq) const {
        const int row0 = u.pm * BM + wr * 64 + fr, col0 = u.pn * BM + wc * 32 + 8 * fq;
#pragma unroll
        for (int ai = 0; ai < 2; ++ai)
#pragma unroll
            for (int m = 0; m < 4; ++m) { bf16_t* rowp = O + (size_t)(row0 + ai * HALF + m * 16) * ldc + col0;
#pragma unroll
                for (int bj = 0; bj < 2; ++bj) { const f32x4 v0 = acc[ai][bj][m][0], v1 = acc[ai][bj][m][1];
                    u32x4 w; w.x = cvt_pk_bf16(v0[0], v0[1]); w.y = cvt_pk_bf16(v0[2], v0[3]); w.z = cvt_pk_bf16(v1[0], v1[1]); w.w = cvt_pk_bf16(v1[2], v1[3]);
                    *(u32x4*)(rowp + bj * HALF) = w; } }
    }
};
__device__ __forceinline__ float silu_mul(float a, float u) {
    const float e = __builtin_amdgcn_exp2f(a * -1.44269504089f);
    return a * __builtin_amdgcn_rcpf(1.0f + e) * u;
}
struct EpiSwiglu {
    static constexpr bool PERM = true, AFTER_DRAIN = false;
    bf16_t* O; int ldc;
    __device__ __forceinline__ void operator()(const f32x4 (&acc)[2][2][4][2], const Unit& u, int wr, int wc, int fr, int fq) const {
        const int row0 = u.pm * BM + wr * 64 + fr, col0 = u.pn * HALF + wc * 32 + 8 * fq;
#pragma unroll
        for (int ai = 0; ai < 2; ++ai)
#pragma unroll
            for (int m = 0; m < 4; ++m) { bf16_t* rowp = O + (size_t)(row0 + ai * HALF + m * 16) * ldc + col0;
                const f32x4 a0 = acc[ai][0][m][0], a1 = acc[ai][0][m][1], u0 = acc[ai][1][m][0], u1 = acc[ai][1][m][1];
                u32x4 w;
                w.x = cvt_pk_bf16(silu_mul(a0[0], u0[0]), silu_mul(a0[1], u0[1])); w.y = cvt_pk_bf16(silu_mul(a0[2], u0[2]), silu_mul(a0[3], u0[3]));
                w.z = cvt_pk_bf16(silu_mul(a1[0], u1[0]), silu_mul(a1[1], u1[1])); w.w = cvt_pk_bf16(silu_mul(a1[2], u1[2]), silu_mul(a1[3], u1[3]));
                *(u32x4*)rowp = w; }
    }
};
struct EpiConvIn {
    static constexpr bool PERM = true, AFTER_DRAIN = false;
    bf16_t* U; bf16_t* Bg;
    __device__ __forceinline__ void operator()(const f32x4 (&acc)[2][2][4][2], const Unit& u, int wr, int wc, int fr, int fq) const {
        const int row0 = u.pm * BM + wr * 64 + fr;
        if (u.pn < 8) {
            const int col0 = u.pn * HALF + wc * 32 + 8 * fq;
#pragma unroll
            for (int ai = 0; ai < 2; ++ai)
#pragma unroll
                for (int m = 0; m < 4; ++m) { bf16_t* rowp = U + (size_t)(row0 + ai * HALF + m * 16) * 1024 + col0;
                    const f32x4 p0 = acc[ai][0][m][0] * acc[ai][1][m][0], p1 = acc[ai][0][m][1] * acc[ai][1][m][1];
                    u32x4 w; w.x = cvt_pk_bf16(p0[0], p0[1]); w.y = cvt_pk_bf16(p0[2], p0[3]); w.z = cvt_pk_bf16(p1[0], p1[1]); w.w = cvt_pk_bf16(p1[2], p1[3]);
                    *(u32x4*)rowp = w; }
        } else {
            const int col0 = (u.pn - 8) * BM + wc * 32 + 8 * fq;
#pragma unroll
            for (int ai = 0; ai < 2; ++ai)
#pragma unroll
                for (int m = 0; m < 4; ++m) { bf16_t* rowp = Bg + (size_t)(row0 + ai * HALF + m * 16) * 1024 + col0;
#pragma unroll
                    for (int bj = 0; bj < 2; ++bj) { const f32x4 v0 = acc[ai][bj][m][0], v1 = acc[ai][bj][m][1];
                        u32x4 w; w.x = cvt_pk_bf16(v0[0], v0[1]); w.y = cvt_pk_bf16(v0[2], v0[3]); w.z = cvt_pk_bf16(v1[0], v1[1]); w.w = cvt_pk_bf16(v1[2], v1[3]);
                        *(u32x4*)(rowp + bj * HALF) = w; } }
        }
    }
};
struct EpiQK {
    static constexpr bool PERM = false, AFTER_DRAIN = false;
    bf16_t* Q; bf16_t* K; const float* cosT; const float* sinT;
    __device__ __forceinline__ void operator()(const f32x4 (&acc)[2][2][4][2], const Unit& u, int wr, int wc, int fr, int fq) const {
        const bool isq = u.pn < 4; bf16_t* base = isq ? Q : K; const float sc = isq ? 0.125f : 1.0f;
        const int row0 = u.pm * BM + wr * 64 + fr, col0 = (u.pn & 3) * BM + wc * 32 + 4 * fq;
#pragma unroll
        for (int ai = 0; ai < 2; ++ai)
#pragma unroll
            for (int m = 0; m < 4; ++m) { const int row = row0 + ai * HALF + m * 16;
                f32x4 c4 = (f32x4){1.f, 1.f, 1.f, 1.f}, s4 = (f32x4){0.f, 0.f, 0.f, 0.f};
                if (row < EP_TL) { const int t = row & 2047, pos = (wc & 1) ? (t & 63) : (t >> 6);
                    c4 = *(const f32x4*)(cosT + pos * 16 + 4 * fq); s4 = *(const f32x4*)(sinT + pos * 16 + 4 * fq); }
                c4 = c4 * sc; s4 = s4 * sc;
                bf16_t* rowp = base + (size_t)row * 1024 + col0;
#pragma unroll
                for (int bj = 0; bj < 2; ++bj) { const f32x4 x1 = acc[ai][bj][m][0], x2 = acc[ai][bj][m][1];
                    const f32x4 o1 = x1 * c4 - x2 * s4, o2 = x2 * c4 + x1 * s4;
                    u32x2 w1, w2; w1.x = cvt_pk_bf16(o1[0], o1[1]); w1.y = cvt_pk_bf16(o1[2], o1[3]); w2.x = cvt_pk_bf16(o2[0], o2[1]); w2.y = cvt_pk_bf16(o2[2], o2[3]);
                    *(u32x2*)(rowp + bj * HALF) = w1; *(u32x2*)(rowp + bj * HALF + 16) = w2; }
                if (m & 1) asm volatile("" ::: "memory"); }
    }
};
struct EpiRes {
    static constexpr bool PERM = false, AFTER_DRAIN = false;
    float* Z; const float* stats; const float* g; const float* b; const float* gate; float w, alpha;
    __device__ __forceinline__ void operator()(const f32x4 (&acc)[2][2][4][2], const Unit& u, int wr, int wc, int fr, int fq) const {
        const int row0 = u.pm * BM + wr * 64 + fr, col0 = u.pn * BM + wc * 32 + 4 * fq;
        const int set = u.pm < (EP_TL / BM) ? (u.pm >> 3) : 16;
        const float* gp = gate + (size_t)set * EP_MODSET + col0;
        f32x2 st[2][4];
#pragma unroll
        for (int ai = 0; ai < 2; ++ai)
#pragma unroll
            for (int m = 0; m < 4; ++m) st[ai][m] = *(const f32x2*)(stats + 2 * (size_t)(row0 + ai * HALF + m * 16));
#pragma unroll
        for (int bj = 0; bj < 2; ++bj)
#pragma unroll
            for (int n = 0; n < 2; ++n) { const int co = bj * HALF + n * 16;
                const f32x4 gv = *(const f32x4*)(g + col0 + co), bv = *(const f32x4*)(b + col0 + co); f32x4 gt = *(const f32x4*)(gp + co); gt = gt * w;
#pragma unroll
                for (int ai = 0; ai < 2; ++ai)
#pragma unroll
                    for (int m = 0; m < 4; ++m) { float* zp = Z + (size_t)(row0 + ai * HALF + m * 16) * 1024 + col0 + co;
                        const f32x4 z = *(const f32x4*)zp; const f32x4 x = (z - st[ai][m].x) * st[ai][m].y * gv + bv;
                        *(f32x4*)zp = x * alpha + gt * acc[ai][bj][m][n]; } }
    }
};

template <class Epi, class Sched, bool ALIGN_EPI = false, bool SP2 = false>
__device__ __forceinline__ void gemm_phase(PG8_LAS unsigned char* lds, const Gemm g, const Sched& S, const Epi& E, const int tid_in) {
    const int tid = tid_in, wid = __builtin_amdgcn_readfirstlane(tid >> 6), lane = tid & 63, wr = wid >> 2, wc = wid & 3, fr = lane & 15, fq = lane >> 4;
    const int K = g.K, nt = K / BK;
    unsigned voffA[2], voffB[2];
#pragma unroll
    for (int i = 0; i < 2; ++i) { int R, C; stage_rc(tid * 16 + i * 8192, R, C); const int Rb = Epi::PERM ? ((R & ~31) + perm32(R & 31)) : R;
        voffA[i] = (unsigned)(R * K + C) * 2u; voffB[i] = (unsigned)(Rb * K + C) * 2u; }
    const size_t kstep = (size_t)(BK * 2);
    const size_t hstep = (size_t)HALF * K * 2;
    const size_t tstep = 2 * hstep;
    const unsigned ldsw = (unsigned)wid * 1024u;
    const int aoff = lds_byte(wr * 64 + fr, fq * 8), boff = lds_byte(wc * 32 + fr, fq * 8);
#define PG8_SA(b, h) (((b) * 2 + (h)) * HTB)
#define PG8_SB(b, h) ((4 + (b) * 2 + (h)) * HTB)
#define PG8_STAGE(bufoff, gbase, voff) do { _Pragma("unroll") for (int _i = 0; _i < 2; ++_i) \
        __builtin_amdgcn_global_load_lds((const unsigned*)((const char*)(gbase) + (voff)[_i]), (PG8_LAS unsigned*)(lds + (bufoff) + ldsw + _i * 8192), 16, 0, 0); } while (0)
#define PG8_LDA(dst, b, h) do { _Pragma("unroll") for (int m = 0; m < 4; ++m) _Pragma("unroll") for (int k = 0; k < 2; ++k) dst[m][k] = *(const PG8_LAS bf16x8*)(lds + PG8_SA(b, h) + aoff + m * 2048 + k * 1024); } while (0)
#define PG8_LDB(dst, b, h) do { _Pragma("unroll") for (int n = 0; n < 2; ++n) _Pragma("unroll") for (int k = 0; k < 2; ++k) dst[n][k] = *(const PG8_LAS bf16x8*)(lds + PG8_SB(b, h) + boff + n * 2048 + k * 1024); } while (0)
#define PG8_MMA(ai, bj, At, Bt) do { __builtin_amdgcn_s_setprio(1); _Pragma("unroll") for (int m = 0; m < 4; ++m) _Pragma("unroll") for (int n = 0; n < 2; ++n) _Pragma("unroll") for (int k = 0; k < 2; ++k) \
        acc[ai][bj][m][n] = __builtin_amdgcn_mfma_f32_16x16x32_bf16(Bt[n][k], At[m][k], acc[ai][bj][m][n], 0, 0, 0); __builtin_amdgcn_s_setprio(0); } while (0)
#define PG8_WAIT_V(n) asm volatile("s_waitcnt vmcnt(" #n ")" ::: "memory")
#define PG8_WAIT_L(n) asm volatile("s_waitcnt lgkmcnt(" #n ")" ::: "memory")
#define PG8_BAR __builtin_amdgcn_s_barrier()
#define PG8_SCHED __builtin_amdgcn_sched_barrier(0)
    Unit cur, nxt; int ui = 0;
    if (!S.next(0, cur)) return;
    f32x4 acc[2][2][4][2];
#pragma unroll
    for (int a = 0; a < 2; ++a)
#pragma unroll
        for (int b = 0; b < 2; ++b)
#pragma unroll
            for (int m = 0; m < 4; ++m)
#pragma unroll
                for (int n = 0; n < 2; ++n) acc[a][b][m][n] = (f32x4){0.f, 0.f, 0.f, 0.f};
    bf16x8 At[4][2], B0[2][2], B1[2][2];
    const char* cA = (const char*)g.A + (size_t)cur.pm * tstep; const char* cB = (const char*)g.Bt + (size_t)cur.pn * tstep;
    S.a_ready(cur);
    if constexpr (SP2) {
        PG8_STAGE(PG8_SB(0, 0), cB, voffB); PG8_STAGE(PG8_SB(0, 1), cB + hstep, voffB); PG8_STAGE(PG8_SA(0, 0), cA, voffA); PG8_STAGE(PG8_SA(0, 1), cA + hstep, voffA);
        if (wr == 1) PG8_BAR;
        PG8_WAIT_V(2); PG8_BAR;
        PG8_STAGE(PG8_SB(1, 0), cB + kstep, voffB); PG8_STAGE(PG8_SA(1, 0), cA + kstep, voffA); PG8_STAGE(PG8_SB(1, 1), cB + hstep + kstep, voffB);
        PG8_WAIT_V(6); PG8_BAR;
    } else {
        PG8_STAGE(PG8_SB(0, 0), cB, voffB); PG8_STAGE(PG8_SA(0, 0), cA, voffA); PG8_STAGE(PG8_SB(0, 1), cB + hstep, voffB); PG8_STAGE(PG8_SA(0, 1), cA + hstep, voffA);
        if (wr == 1) PG8_BAR;
        PG8_WAIT_V(4); PG8_BAR;
        PG8_STAGE(PG8_SB(1, 0), cB + kstep, voffB); PG8_STAGE(PG8_SA(1, 0), cA + kstep, voffA); PG8_STAGE(PG8_SB(1, 1), cB + hstep + kstep, voffB);
        PG8_WAIT_V(6); PG8_BAR;
    }
    for (;;) {
        const bool has_next = S.next(ui + 1, nxt);
        const char* nA = has_next ? (const char*)g.A + (size_t)nxt.pm * tstep : cA; const char* nB = has_next ? (const char*)g.Bt + (size_t)nxt.pn * tstep : cB;
        for (int t = 0; t < nt; t += 2) {
            const bool last = (t == nt - 2);
            const char* a1 = cA + (size_t)(t + 1) * kstep;
            const char* a2 = last ? nA : cA + (size_t)(t + 2) * kstep; const char* b2 = last ? nB : cB + (size_t)(t + 2) * kstep;
            const char* a3 = a2 + kstep; const char* b3 = b2 + kstep;
            if (last && has_next) S.a_ready(nxt);
            if constexpr (SP2) {
            PG8_LDB(B0, 0, 0); PG8_LDB(B1, 0, 1); PG8_SCHED; PG8_LDA(At, 0, 0); PG8_STAGE(PG8_SA(1, 1), a1 + hstep, voffA);
            PG8_WAIT_V(8); PG8_WAIT_L(0); PG8_BAR; PG8_MMA(0, 0, At, B0); PG8_MMA(0, 1, At, B1); PG8_BAR; PG8_SCHED;
            PG8_LDA(At, 0, 1); PG8_STAGE(PG8_SB(0, 0), b2, voffB); PG8_STAGE(PG8_SB(0, 1), b2 + hstep, voffB); PG8_STAGE(PG8_SA(0, 0), a2, voffA);
            PG8_WAIT_V(8); PG8_WAIT_L(0); PG8_BAR; PG8_MMA(1, 0, At, B0); PG8_MMA(1, 1, At, B1); PG8_BAR; PG8_SCHED;
            PG8_LDB(B0, 1, 0); PG8_LDB(B1, 1, 1); PG8_SCHED; PG8_LDA(At, 1, 0); PG8_STAGE(PG8_SA(0, 1), a2 + hstep, voffA);
            PG8_WAIT_V(8); PG8_WAIT_L(0); PG8_BAR; PG8_MMA(0, 0, At, B0); PG8_MMA(0, 1, At, B1); PG8_BAR; PG8_SCHED;
            PG8_LDA(At, 1, 1); PG8_STAGE(PG8_SB(1, 0), b3, voffB); PG8_STAGE(PG8_SB(1, 1), b3 + hstep, voffB); PG8_STAGE(PG8_SA(1, 0), a3, voffA);
            PG8_WAIT_V(8); PG8_WAIT_L(0); PG8_BAR; PG8_MMA(1, 0, At, B0); PG8_MMA(1, 1, At, B1); PG8_BAR; PG8_SCHED;
            } else {
            PG8_LDB(B0, 0, 0); PG8_SCHED; PG8_LDA(At, 0, 0); PG8_STAGE(PG8_SA(1, 1), a1 + hstep, voffA);
            PG8_WAIT_L(8); PG8_BAR; PG8_WAIT_L(0); PG8_MMA(0, 0, At, B0); PG8_BAR; PG8_SCHED;
            PG8_LDB(B1, 0, 1); PG8_STAGE(PG8_SB(0, 0), b2, voffB);
            PG8_BAR; PG8_WAIT_L(0); PG8_MMA(0, 1, At, B1); PG8_BAR;
            PG8_LDA(At, 0, 1); PG8_STAGE(PG8_SA(0, 0), a2, voffA);
            PG8_BAR; PG8_WAIT_L(0); PG8_MMA(1, 0, At, B0); PG8_BAR; PG8_SCHED;
            PG8_STAGE(PG8_SB(0, 1), b2 + hstep, voffB);
            PG8_WAIT_V(6); PG8_BAR; PG8_MMA(1, 1, At, B1); PG8_BAR;
            PG8_LDB(B0, 1, 0); PG8_SCHED; PG8_LDA(At, 1, 0); PG8_STAGE(PG8_SA(0, 1), a2 + hstep, voffA);
            PG8_WAIT_L(8); PG8_BAR; PG8_WAIT_L(0); PG8_MMA(0, 0, At, B0); PG8_BAR; PG8_SCHED;
            PG8_LDB(B1, 1, 1); PG8_STAGE(PG8_SB(1, 0), b3, voffB);
            PG8_BAR; PG8_WAIT_L(0); PG8_MMA(0, 1, At, B1); PG8_BAR;
            PG8_LDA(At, 1, 1); PG8_STAGE(PG8_SA(1, 0), a3, voffA);
            PG8_BAR; PG8_WAIT_L(0); PG8_MMA(1, 0, At, B0); PG8_BAR; PG8_SCHED;
            PG8_STAGE(PG8_SB(1, 1), b3 + hstep, voffB);
            PG8_WAIT_V(6); PG8_BAR; PG8_MMA(1, 1, At, B1); PG8_BAR;
            }
        }
        if constexpr (ALIGN_EPI) { if (wr == 0) PG8_BAR; }
        if constexpr (!Epi::AFTER_DRAIN) { E(acc, cur, wr, wc, fr, fq); S.done(cur); }
        if (!has_next) break;
#pragma unroll
        for (int a = 0; a < 2; ++a)
#pragma unroll
            for (int b = 0; b < 2; ++b)
#pragma unroll
                for (int m = 0; m < 4; ++m)
#pragma unroll
                    for (int n = 0; n < 2; ++n) acc[a][b][m][n] = (f32x4){0.f, 0.f, 0.f, 0.f};
        cur = nxt; cA = nA; cB = nB; ++ui;
        if constexpr (ALIGN_EPI) { if (wr == 1) PG8_BAR; }
    }
    PG8_WAIT_V(0);
    if constexpr (!ALIGN_EPI) { if (wr == 0) PG8_BAR; }
    PG8_BAR;
    if constexpr (Epi::AFTER_DRAIN) { E.fused(acc, cur, wr, wc, fr, fq, lds, wid, lane); S.done(cur); }
#undef PG8_SA
#undef PG8_SB
#undef PG8_STAGE
#undef PG8_LDA
#undef PG8_LDB
#undef PG8_MMA
#undef PG8_WAIT_V
#undef PG8_WAIT_L
#undef PG8_BAR
#undef PG8_SCHED
}
}

#define LAS __attribute__((address_space(3)))
typedef unsigned short bf16;
typedef float f32x4 __attribute__((ext_vector_type(4)));
typedef float f32x2 __attribute__((ext_vector_type(2)));
typedef short bf16x8 __attribute__((ext_vector_type(8)));
typedef unsigned u32x4 __attribute__((ext_vector_type(4)));
typedef unsigned u32x2 __attribute__((ext_vector_type(2)));
constexpr int D = 1024, NB = 16, SEQ = 2048, DEPTH = 4, CTXL = 256, NH = 16, FF = 2816;
constexpr int TL = NB * SEQ, TC = NB * CTXL, TT = TL + TC;
constexpr int NSET = 17, MODSET = 9 * D;
constexpr float LN_EPS = 1e-6f;
constexpr float DN_ALPHA = 1.681792830507429f;
constexpr int NWAVES = 8, NTHR = 512;
constexpr int LDS_BYTES = 147456;

constexpr size_t MiB = 1u << 20;
constexpr size_t WS_MOD = 1 * MiB;
constexpr size_t WS_STATS = 4 * MiB;
constexpr size_t WS_IDENT = 5 * MiB;
constexpr size_t WS_ROPE = 5 * MiB + 8192;
constexpr size_t WS_W1 = 6 * MiB;
constexpr size_t WS_W2 = WS_W1 + 88 * MiB;
constexpr size_t WS_WQK = WS_W2 + 44 * MiB;
constexpr size_t WS_WV = WS_WQK + 8 * MiB;
constexpr size_t WS_WO = WS_WV + 4 * MiB;
constexpr size_t WS_WC = WS_WO + 4 * MiB;
constexpr size_t WS_WCO = WS_WC + 12 * MiB;
constexpr size_t WS_Z = WS_WCO + 4 * MiB;
constexpr size_t WS_HB = WS_Z + 144 * MiB;
constexpr size_t WS_BIG = WS_HB + 72 * MiB;
constexpr size_t WS_END = WS_BIG + 216 * MiB;
static_assert(WS_W1 + (size_t)8 * 5632 * 1024 * 2 == WS_W2 && WS_Z + (size_t)TT * D * 4 == WS_HB && WS_HB + (size_t)TT * D * 2 == WS_BIG, "ws map");

__device__ __forceinline__ unsigned pk_bf16(float lo, float hi) { return pg8::cvt_pk_bf16(lo, hi); }
__device__ __forceinline__ float bf_lo(unsigned w) { return __uint_as_float(w << 16); }
__device__ __forceinline__ float bf_hi(unsigned w) { return __uint_as_float(w & 0xffff0000u); }
__device__ __forceinline__ float wave_sum(float v) {
#pragma unroll
    for (int o = 1; o < 64; o <<= 1) v += __shfl_xor(v, o);
    return v;
}

struct Args { const float* in[16]; float* out; unsigned char* ws; float inv_freq[16]; int ph_lo, ph_hi; };

__device__ __forceinline__ void transpose_item(const float* W, int K, int Nsrc, int srccol0, bf16* WT, int destrow0, int k0, LAS float* scr, int lane) {
    const int kr = lane >> 3, c4 = (lane & 7) * 4;
#pragma unroll
    for (int i = 0; i < 8; ++i) { const int k = kr + 8 * i; const f32x4 v = *(const f32x4*)(W + (size_t)(k0 + k) * Nsrc + srccol0 + c4);
        scr[k * 33 + c4 + 0] = v[0]; scr[k * 33 + c4 + 1] = v[1]; scr[k * 33 + c4 + 2] = v[2]; scr[k * 33 + c4 + 3] = v[3]; }
    asm volatile("s_waitcnt lgkmcnt(0)" ::: "memory");
    const int c = lane & 7;
#pragma unroll
    for (int j = 0; j < 4; ++j) { const int n = (lane >> 3) + 8 * j; const LAS float* s = scr + (8 * c) * 33 + n;
        u32x4 o; o.x = pk_bf16(s[0 * 33], s[1 * 33]); o.y = pk_bf16(s[2 * 33], s[3 * 33]); o.z = pk_bf16(s[4 * 33], s[5 * 33]); o.w = pk_bf16(s[6 * 33], s[7 * 33]);
        *(u32x4*)(WT + (size_t)(destrow0 + n) * K + k0 + 8 * c) = o; }
    asm volatile("s_waitcnt lgkmcnt(0)" ::: "memory");
}
constexpr int IT_W1 = 16 * 176, IT_W2 = 44 * 32, IT_QKV = 16 * 96, IT_SQ = 16 * 32, IT_WC = 16 * 96;
constexpr int SEG_A = 8 * IT_W1, SEG_B = SEG_A + 8 * IT_W2, SEG_C = SEG_B + 2 * IT_QKV, SEG_D = SEG_C + 2 * IT_SQ, SEG_E = SEG_D + 2 * IT_WC, SEG_F = SEG_E + 2 * IT_SQ;
__device__ __forceinline__ void transpose_dispatch(const Args& a, int it, LAS float* scr, int lane) {
    unsigned char* ws = a.ws;
    if (it < SEG_A) { const int mi = it / IT_W1, rem = it % IT_W1, kb = rem / 176, nb = rem % 176, n0 = 32 * nb, pn = n0 >> 8, w = n0 & 255;
        const int src = (w < 128) ? (128 * pn + w) : (FF + 128 * pn + (w - 128));
        transpose_item(a.in[8] + (size_t)mi * D * 2 * FF, D, 2 * FF, src, (bf16*)(ws + WS_W1) + (size_t)mi * 2 * FF * D, n0, 64 * kb, scr, lane); return; }
    if (it < SEG_B) { const int r = it - SEG_A, mi = r / IT_W2, rem = r % IT_W2, kb = rem / 32, nb = rem % 32;
        transpose_item(a.in[9] + (size_t)mi * FF * D, FF, D, 32 * nb, (bf16*)(ws + WS_W2) + (size_t)mi * D * FF, 32 * nb, 64 * kb, scr, lane); return; }
    if (it < SEG_C) { const int r = it - SEG_B, mi = r / IT_QKV, rem = r % IT_QKV, kb = rem / 96, nb = rem % 96, n0 = 32 * nb;
        if (n0 < 2048) transpose_item(a.in[10] + (size_t)mi * D * 3 * D, D, 3 * D, n0, (bf16*)(ws + WS_WQK) + (size_t)mi * 2048 * D, n0, 64 * kb, scr, lane);
        else transpose_item(a.in[10] + (size_t)mi * D * 3 * D, D, 3 * D, n0, (bf16*)(ws + WS_WV) + (size_t)mi * D * D, n0 - 2048, 64 * kb, scr, lane);
        return; }
    if (it < SEG_D) { const int r = it - SEG_C, mi = r / IT_SQ, rem = r % IT_SQ, kb = rem / 32, nb = rem % 32;
        transpose_item(a.in[11] + (size_t)mi * D * D, D, D, 32 * nb, (bf16*)(ws + WS_WO) + (size_t)mi * D * D, 32 * nb, 64 * kb, scr, lane); return; }
    if (it < SEG_E) { const int r = it - SEG_D, mi = r / IT_WC, rem = r % IT_WC, kb = rem / 96, nb = rem % 96, n0 = 32 * nb;
        int src; if (n0 < 2048) { const int pn = n0 >> 8, w = n0 & 255; src = (w < 128) ? (1024 + 128 * pn + w) : (2048 + 128 * pn + (w - 128)); } else src = n0 - 2048;
        transpose_item(a.in[13] + (size_t)mi * D * 3 * D, D, 3 * D, src, (bf16*)(ws + WS_WC) + (size_t)mi * 3 * D * D, n0, 64 * kb, scr, lane); return; }
    { const int r = it - SEG_E, mi = r / IT_SQ, rem = r % IT_SQ, kb = rem / 32, nb = rem % 32;
        transpose_item(a.in[15] + (size_t)mi * D * D, D, D, 32 * nb, (bf16*)(ws + WS_WCO) + (size_t)mi * D * D, 32 * nb, 64 * kb, scr, lane); }
}
__device__ __forceinline__ float silu_f(float v) { return v / (1.0f + __expf(-v)); }

__device__ __forceinline__ void phase0(const Args& a, LAS unsigned char* lds, int tid, int lane, int wave) {
    const int G = gridDim.x, bx = blockIdx.x;
    float* mod = (float*)(a.ws + WS_MOD);
    LAS float* sL = (LAS float*)lds;
    LAS float* red = (LAS float*)(lds + 81920);
    if (bx < 576) {
        for (int e = tid; e < NSET * D; e += NTHR) { const int s = e >> 10, k = e & 1023; const float v = (s < 16) ? a.in[1][s * D + k] : a.in[3][k]; sL[k * 20 + s] = silu_f(v); }
        __syncthreads();
        for (int unit = bx; unit < 576; unit += G) {
            const int i = unit / 144, col0 = (unit % 144) * 64;
            float acc[NSET];
#pragma unroll
            for (int s = 0; s < NSET; ++s) acc[s] = 0.f;
            const float* Wp = a.in[4] + (size_t)i * D * 9 * D + (size_t)(128 * wave) * 9 * D + col0 + lane;
#pragma unroll 8
            for (int kk = 0; kk < 128; ++kk) { const float wv = Wp[(size_t)kk * 9 * D]; const LAS float* sp = sL + (128 * wave + kk) * 20;
                const f32x4 s0 = *(const LAS f32x4*)sp, s1 = *(const LAS f32x4*)(sp + 4), s2 = *(const LAS f32x4*)(sp + 8), s3 = *(const LAS f32x4*)(sp + 12); const float s4 = sp[16];
                acc[0] += s0[0] * wv; acc[1] += s0[1] * wv; acc[2] += s0[2] * wv; acc[3] += s0[3] * wv;
                acc[4] += s1[0] * wv; acc[5] += s1[1] * wv; acc[6] += s1[2] * wv; acc[7] += s1[3] * wv;
                acc[8] += s2[0] * wv; acc[9] += s2[1] * wv; acc[10] += s2[2] * wv; acc[11] += s2[3] * wv;
                acc[12] += s3[0] * wv; acc[13] += s3[1] * wv; acc[14] += s3[2] * wv; acc[15] += s3[3] * wv; acc[16] += s4 * wv; }
#pragma unroll
            for (int s = 0; s < NSET; ++s) red[(wave * NSET + s) * 64 + lane] = acc[s];
            __syncthreads();
            for (int o = tid; o < NSET * 64; o += NTHR) { const int s = o >> 6, l = o & 63; float sum = 0.f;
#pragma unroll
                for (int w = 0; w < 8; ++w) sum += red[(w * NSET + s) * 64 + l];
                mod[((size_t)i * NSET + s) * MODSET + col0 + l] = sum + a.in[5][i * MODSET + col0 + l]; }
            __syncthreads();
        }
    }
    __syncthreads();
    LAS float* scr = (LAS float*)(lds + wave * 16384);
    const int gw = bx * NWAVES + wave, NGW = G * NWAVES;
    for (int it = gw; it < SEG_F; it += NGW) transpose_dispatch(a, it, scr, lane);
    if (bx == 0) {
        float* ident = (float*)(a.ws + WS_IDENT); float* rope = (float*)(a.ws + WS_ROPE);
        if (tid == 0) *(unsigned*)a.ws = 0u;
        for (int e = tid; e < 1024; e += NTHR) { ident[e] = 1.0f; ident[1024 + e] = 0.0f; }
        for (int e = tid; e < 1024; e += NTHR) { const int pos = e >> 4, f = e & 15; const float ang = (float)pos * a.inv_freq[f]; rope[e] = cosf(ang); rope[1024 + e] = sinf(ang); }
    }
}

__device__ __forceinline__ void ln_pass(const Args& a, int mode, int rows, const float* g, const float* b, const float* modl, int slot, int lane, int wave) {
    float* Z = (float*)(a.ws + WS_Z); float* stats = (float*)(a.ws + WS_STATS); bf16* Hb = (bf16*)(a.ws + WS_HB);
    const int gw = blockIdx.x * NWAVES + wave, NGW = gridDim.x * NWAVES;
    for (int row = gw; row < rows; row += NGW) {
        const float* zr = (mode == 0) ? ((row < TL) ? a.in[0] + (size_t)row * D : a.in[2] + (size_t)(row - TL) * D) : Z + (size_t)row * D;
        f32x4 v[4];
#pragma unroll
        for (int j = 0; j < 4; ++j) v[j] = ((const f32x4*)zr)[lane + 64 * j];
        if (mode == 0) {
#pragma unroll
            for (int j = 0; j < 4; ++j) ((f32x4*)(Z + (size_t)row * D))[lane + 64 * j] = v[j];
            if (lane == 0) *(f32x2*)(stats + 2 * (size_t)row) = (f32x2){0.f, 1.f};
        } else {
            float s = 0.f;
#pragma unroll
            for (int j = 0; j < 4; ++j) s += (v[j][0] + v[j][1]) + (v[j][2] + v[j][3]);
            const float mean = wave_sum(s) * (1.0f / D); float s2 = 0.f;
#pragma unroll
            for (int j = 0; j < 4; ++j) { v[j] = v[j] - mean; s2 += (v[j][0] * v[j][0] + v[j][1] * v[j][1]) + (v[j][2] * v[j][2] + v[j][3] * v[j][3]); }
            const float rstd = 1.0f / sqrtf(wave_sum(s2) * (1.0f / D) + LN_EPS);
            if (lane == 0) *(f32x2*)(stats + 2 * (size_t)row) = (f32x2){mean, rstd};
#pragma unroll
            for (int j = 0; j < 4; ++j) { const f32x4 gv = ((const f32x4*)g)[lane + 64 * j], bv = ((const f32x4*)b)[lane + 64 * j]; v[j] = v[j] * rstd * gv + bv; }
        }
        if (mode == 2) {
#pragma unroll
            for (int j = 0; j < 4; ++j) ((f32x4*)(a.out + (size_t)row * D))[lane + 64 * j] = v[j];
        } else {
            const int set = (row < TL) ? (row >> 11) : 16;
            const float* sh = modl + (size_t)set * MODSET + slot * D; const float* sc = sh + D;
#pragma unroll
            for (int j = 0; j < 4; ++j) { const f32x4 shv = ((const f32x4*)sh)[lane + 64 * j], scv = ((const f32x4*)sc)[lane + 64 * j];
                const f32x4 h = v[j] * (scv + 1.0f) + shv; u32x2 w; w.x = pk_bf16(h[0], h[1]); w.y = pk_bf16(h[2], h[3]);
                ((u32x2*)(Hb + (size_t)row * D))[lane + 64 * j] = w; }
        }
    }
}

template <bool WIN>
__device__ __forceinline__ void attn_job(const bf16* Q, const bf16* K, const bf16* VT, bf16* O, const LAS float* rpbL, const LAS bf16* Kc, const LAS bf16* Vc, int b, int h, int qtok0, int r, int cb, int lane) {
    const int q = lane & 15, g = lane >> 4, hoff = h * 64, slot_off = 8 * (q >> 2) + (q & 3);
    const bf16* qp = Q + (size_t)(qtok0 + q) * D + hoff + 8 * g;
    const bf16x8 qf0 = *(const bf16x8*)qp, qf1 = *(const bf16x8*)(qp + 32);
    const int rs = min(max(r - 4, 0), 24), blk_c0 = min(max(16 * cb - 8, 0), 32);
    const int wtok0 = b * SEQ + rs * 64 + blk_c0;
    const float NEG = -1.0e30f, L2E = 1.44269504089f;
    f32x4 oacc[4];
#pragma unroll
    for (int dt = 0; dt < 4; ++dt) oacc[dt] = (f32x4){0.f, 0.f, 0.f, 0.f};
    float mx = NEG, sum = 0.f;
    f32x4 sc[8][2];
#define ATT_PACK(i) ({ u32x4 pw_; pw_.x = pg8::cvt_pk_bf16_safe(sc[i][0][0], sc[i][0][1]); pw_.y = pg8::cvt_pk_bf16_safe(sc[i][0][2], sc[i][0][3]); pw_.z = pg8::cvt_pk_bf16_safe(sc[i][1][0], sc[i][1][1]); pw_.w = pg8::cvt_pk_bf16_safe(sc[i][1][2], sc[i][1][3]); __builtin_bit_cast(bf16x8, pw_); })
    if (WIN) {
        const bf16* kbase = K + (size_t)(wtok0 + slot_off) * D + hoff + 8 * g;
        bf16x8 kb[2][8];
#define ATT_LOADK(buf, i0) do { _Pragma("unroll") for (int ii_ = 0; ii_ < 2; ++ii_) _Pragma("unroll") for (int t_ = 0; t_ < 2; ++t_) { const bf16* kp_ = kbase + (size_t)(64 * ((i0) + ii_) + 4 * t_) * D; \
            kb[buf][(ii_ * 2 + t_) * 2 + 0] = *(const bf16x8*)kp_; kb[buf][(ii_ * 2 + t_) * 2 + 1] = *(const bf16x8*)(kp_ + 32); } } while (0)
        ATT_LOADK(0, 0);
#pragma unroll
        for (int bi = 0; bi < 4; ++bi) {
            if (bi < 3) ATT_LOADK((bi + 1) & 1, 2 * bi + 2);
            __builtin_amdgcn_sched_barrier(0);
#pragma unroll
            for (int ii = 0; ii < 2; ++ii)
#pragma unroll
                for (int t = 0; t < 2; ++t) { f32x4 acc = (f32x4){0.f, 0.f, 0.f, 0.f};
                    acc = __builtin_amdgcn_mfma_f32_16x16x32_bf16(kb[bi & 1][(ii * 2 + t) * 2 + 0], qf0, acc, 0, 0, 0);
                    acc = __builtin_amdgcn_mfma_f32_16x16x32_bf16(kb[bi & 1][(ii * 2 + t) * 2 + 1], qf1, acc, 0, 0, 0); sc[2 * bi + ii][t] = acc; }
            __builtin_amdgcn_sched_barrier(0);
        }
#undef ATT_LOADK
        const bf16* vbase = VT + (size_t)(hoff + q) * TT + wtok0 + 8 * g;
        bf16x8 vb[2][8];
#define ATT_LOADV(buf, i0) do { _Pragma("unroll") for (int ii_ = 0; ii_ < 2; ++ii_) _Pragma("unroll") for (int dt_ = 0; dt_ < 4; ++dt_) \
            vb[buf][ii_ * 4 + dt_] = *(const bf16x8*)(vbase + (size_t)(16 * dt_) * TT + 64 * ((i0) + ii_)); } while (0)
        ATT_LOADV(0, 0);
        __builtin_amdgcn_sched_barrier(0);
        const int qc = 16 * cb + q, win_c0 = min(max(qc - 8, 0), 48);
#pragma unroll
        for (int i = 0; i < 8; ++i) { const int dyo = (rs + i - r + 7) * 31;
#pragma unroll
            for (int t = 0; t < 2; ++t)
#pragma unroll
                for (int j = 0; j < 4; ++j) { const int kc = blk_c0 + 8 * g + 4 * t + j; const bool ok = (kc >= win_c0) && (kc < win_c0 + 16);
                    const int idx = ok ? (dyo + kc - qc + 15) : 0; const float bias = rpbL[idx];
                    const float s = ok ? (sc[i][t][j] + bias) : NEG; sc[i][t][j] = s; mx = fmaxf(mx, s); } }
        mx = fmaxf(mx, __shfl_xor(mx, 16)); mx = fmaxf(mx, __shfl_xor(mx, 32));
        const float mo = mx * L2E;
#pragma unroll
        for (int i = 0; i < 8; ++i)
#pragma unroll
            for (int t = 0; t < 2; ++t)
#pragma unroll
                for (int j = 0; j < 4; ++j) { const float p = __builtin_amdgcn_exp2f(sc[i][t][j] * L2E - mo); sc[i][t][j] = p; sum += p; }
#pragma unroll
        for (int bi = 0; bi < 4; ++bi) {
            if (bi < 3) ATT_LOADV((bi + 1) & 1, 2 * bi + 2);
            __builtin_amdgcn_sched_barrier(0);
#pragma unroll
            for (int ii = 0; ii < 2; ++ii) { const bf16x8 pf = ATT_PACK(2 * bi + ii);
#pragma unroll
                for (int dt = 0; dt < 4; ++dt) oacc[dt] = __builtin_amdgcn_mfma_f32_16x16x32_bf16(vb[bi & 1][ii * 4 + dt], pf, oacc[dt], 0, 0, 0); }
            __builtin_amdgcn_sched_barrier(0);
        }
#undef ATT_LOADV
    }
#pragma unroll
    for (int i = 0; i < 8; ++i)
#pragma unroll
        for (int t = 0; t < 2; ++t) { const LAS bf16* kp = Kc + (32 * i + slot_off + 4 * t) * 72 + 8 * g;
            const bf16x8 k0 = *(const LAS bf16x8*)kp, k1 = *(const LAS bf16x8*)(kp + 32);
            f32x4 acc = (f32x4){0.f, 0.f, 0.f, 0.f};
            acc = __builtin_amdgcn_mfma_f32_16x16x32_bf16(k0, qf0, acc, 0, 0, 0); acc = __builtin_amdgcn_mfma_f32_16x16x32_bf16(k1, qf1, acc, 0, 0, 0); sc[i][t] = acc; }
    float m2 = mx;
#pragma unroll
    for (int i = 0; i < 8; ++i)
#pragma unroll
        for (int t = 0; t < 2; ++t)
#pragma unroll
            for (int j = 0; j < 4; ++j) m2 = fmaxf(m2, sc[i][t][j]);
    m2 = fmaxf(m2, __shfl_xor(m2, 16)); m2 = fmaxf(m2, __shfl_xor(m2, 32));
    const float resc = __builtin_amdgcn_exp2f((mx - m2) * L2E), mo2 = m2 * L2E;
    sum *= resc;
#pragma unroll
    for (int dt = 0; dt < 4; ++dt) oacc[dt] = oacc[dt] * resc;
#pragma unroll
    for (int i = 0; i < 8; ++i)
#pragma unroll
        for (int t = 0; t < 2; ++t)
#pragma unroll
            for (int j = 0; j < 4; ++j) { const float p = __builtin_amdgcn_exp2f(sc[i][t][j] * L2E - mo2); sc[i][t][j] = p; sum += p; }
#pragma unroll
    for (int i = 0; i < 8; ++i) { const bf16x8 pf = ATT_PACK(i);
#pragma unroll
        for (int dt = 0; dt < 4; ++dt) { const bf16x8 vf = *(const LAS bf16x8*)(Vc + (16 * dt + q) * 264 + 32 * i + 8 * g);
            oacc[dt] = __builtin_amdgcn_mfma_f32_16x16x32_bf16(vf, pf, oacc[dt], 0, 0, 0); } }
#undef ATT_PACK
    sum += __shfl_xor(sum, 16); sum += __shfl_xor(sum, 32);
    const float inv = 1.0f / sum;
    bf16* op = O + (size_t)(qtok0 + q) * D + hoff + 4 * g;
#pragma unroll
    for (int dt = 0; dt < 4; ++dt) { u32x2 w; w.x = pg8::cvt_pk_bf16_safe(oacc[dt][0] * inv, oacc[dt][1] * inv); w.y = pg8::cvt_pk_bf16_safe(oacc[dt][2] * inv, oacc[dt][3] * inv); *(u32x2*)(op + 16 * dt) = w; }
}
__device__ __forceinline__ void attn_phase(const Args& a, LAS unsigned char* lds, const float* rpb, bool ctxq, int tid, int lane, int wave) {
    const bf16* Q = (const bf16*)(a.ws + WS_BIG); const bf16* K = Q + (size_t)TT * D; const bf16* VT = K + (size_t)TT * D; bf16* O = (bf16*)(a.ws + WS_HB);
    LAS float* rpbL = (LAS float*)lds;
    LAS bf16* Kc = (LAS bf16*)(lds + 2048);
    LAS bf16* Vc = (LAS bf16*)(lds + 2048 + 36864);
    const int njobs = 128 + (ctxq ? 16 : 0);
    for (int bh = blockIdx.x; bh < NB * NH; bh += gridDim.x) {
        const int b = bh >> 4, h = bh & 15;
        __syncthreads();
        for (int e = tid; e < 465; e += NTHR) rpbL[e] = rpb[h * 465 + e];
        for (int c = tid; c < 2048; c += NTHR) { const int key = c >> 3, ch = c & 7;
            *(LAS u32x4*)(Kc + key * 72 + ch * 8) = *(const u32x4*)(K + (size_t)(TL + b * CTXL + key) * D + h * 64 + ch * 8); }
        for (int c = tid; c < 2048; c += NTHR) { const int d = c >> 5, ch = c & 31;
            *(LAS u32x4*)(Vc + d * 264 + ch * 8) = *(const u32x4*)(VT + (size_t)(h * 64 + d) * TT + TL + b * CTXL + ch * 8); }
        __syncthreads();
        for (int jj = wave; jj < njobs; jj += NWAVES) {
            if (jj < 128) attn_job<true>(Q, K, VT, O, rpbL, Kc, Vc, b, h, b * SEQ + (jj >> 2) * 64 + (jj & 3) * 16, jj >> 2, jj & 3, lane);
            else attn_job<false>(Q, K, VT, O, rpbL, Kc, Vc, b, h, TL + b * CTXL + (jj - 128) * 16, 0, 0, lane);
        }
    }
}

__device__ __forceinline__ void conv_phase(const Args& a, const float* cw, int rows, int tid) {
    const bf16* U = (const bf16*)(a.ws + WS_BIG); const bf16* Bg = U + (size_t)TT * D; bf16* Gm = (bf16*)(a.ws + WS_HB);
    const long total = (long)rows * 128, nthr = (long)gridDim.x * NTHR;
    for (long item = (long)blockIdx.x * NTHR + tid; item < total; item += nthr) {
        const int t = (int)(item >> 7), d0 = ((int)item & 127) * 8;
        int p, L; if (t < TL) { p = t & (SEQ - 1); L = SEQ; } else { p = (t - TL) & (CTXL - 1); L = CTXL; }
        const u32x4 z4 = (u32x4){0u, 0u, 0u, 0u};
        const u32x4 uc = *(const u32x4*)(U + (size_t)t * D + d0), bg = *(const u32x4*)(Bg + (size_t)t * D + d0);
        const u32x4 up = (p > 0) ? *(const u32x4*)(U + (size_t)(t - 1) * D + d0) : z4;
        const u32x4 un = (p < L - 1) ? *(const u32x4*)(U + (size_t)(t + 1) * D + d0) : z4;
        const f32x4 w0a = *(const f32x4*)(cw + d0), w0b = *(const f32x4*)(cw + d0 + 4), w1a = *(const f32x4*)(cw + D + d0), w1b = *(const f32x4*)(cw + D + d0 + 4),
                    w2a = *(const f32x4*)(cw + 2 * D + d0), w2b = *(const f32x4*)(cw + 2 * D + d0 + 4);
        u32x4 o;
#define CONV2(k, wA, wB, ia, ib) (pk_bf16(bf_lo(bg[k]) * (wA##0[ia] * bf_lo(up[k]) + wA##1[ia] * bf_lo(uc[k]) + wA##2[ia] * bf_lo(un[k])), bf_hi(bg[k]) * (wB##0[ib] * bf_hi(up[k]) + wB##1[ib] * bf_hi(uc[k]) + wB##2[ib] * bf_hi(un[k]))))
        o.x = pk_bf16(bf_lo(bg.x) * (w0a[0] * bf_lo(up.x) + w1a[0] * bf_lo(uc.x) + w2a[0] * bf_lo(un.x)), bf_hi(bg.x) * (w0a[1] * bf_hi(up.x) + w1a[1] * bf_hi(uc.x) + w2a[1] * bf_hi(un.x)));
        o.y = pk_bf16(bf_lo(bg.y) * (w0a[2] * bf_lo(up.y) + w1a[2] * bf_lo(uc.y) + w2a[2] * bf_lo(un.y)), bf_hi(bg.y) * (w0a[3] * bf_hi(up.y) + w1a[3] * bf_hi(uc.y) + w2a[3] * bf_hi(un.y)));
        o.z = pk_bf16(bf_lo(bg.z) * (w0b[0] * bf_lo(up.z) + w1b[0] * bf_lo(uc.z) + w2b[0] * bf_lo(un.z)), bf_hi(bg.z) * (w0b[1] * bf_hi(up.z) + w1b[1] * bf_hi(uc.z) + w2b[1] * bf_hi(un.z)));
        o.w = pk_bf16(bf_lo(bg.w) * (w0b[2] * bf_lo(up.w) + w1b[2] * bf_lo(uc.w) + w2b[2] * bf_lo(un.w)), bf_hi(bg.w) * (w0b[3] * bf_hi(up.w) + w1b[3] * bf_hi(uc.w) + w2b[3] * bf_hi(un.w)));
#undef CONV2
        *(u32x4*)(Gm + (size_t)t * D + d0) = o;
    }
}

#ifndef DBG_CHECK
#define DBG_CHECK 0
#endif
__device__ __forceinline__ unsigned hash_u(unsigned x) { x ^= x >> 16; x *= 0x7feb352dU; x ^= x >> 15; x *= 0x846ca68bU; x ^= x >> 16; return x; }
__device__ __forceinline__ float bfr(float f) { unsigned u = __float_as_uint(f); u = (u + 0x7fffu + ((u >> 16) & 1u)) & 0xffff0000u; return __uint_as_float(u); }
__device__ __forceinline__ float bf2f(bf16 v) { return __uint_as_float((unsigned)v << 16); }
__device__ __forceinline__ void flag_if(bool badv, unsigned* flags, unsigned bit) { if (badv) atomicOr(flags, bit); }
#define CHK_LOOP(n) for (unsigned sidx = blockIdx.x * NTHR + threadIdx.x; sidx < (n); sidx += gridDim.x * NTHR)
__device__ __forceinline__ void chk_mod(const Args& a, unsigned* flags) {
    const float* mod = (const float*)(a.ws + WS_MOD);
    CHK_LOOP(4096u) { const unsigned h = hash_u(sidx * 3u + 1u); const int i = h & 3, s = (h >> 2) % 17, col = (h >> 8) % 9216;
        float acc = 0.f;
        for (int k = 0; k < D; ++k) { const float c = (s < 16) ? a.in[1][s * D + k] : a.in[3][k]; acc += (c / (1.0f + expf(-c))) * a.in[4][((size_t)i * D + k) * 9 * D + col]; }
        acc += a.in[5][i * 9 * D + col];
        const float got = mod[((size_t)i * NSET + s) * MODSET + col];
        flag_if(!(fabsf(got - acc) <= 2e-3f * fabsf(acc) + 2e-3f), flags, 1u); }
}
__device__ __forceinline__ void chk_gemm1(const Args& a, unsigned* flags) {
    const bf16* Hb = (const bf16*)(a.ws + WS_HB); const bf16* hid = (const bf16*)(a.ws + WS_BIG);
    CHK_LOOP(4096u) { const unsigned h = hash_u(sidx * 5u + 2u); const int row = h % TT, hc = (h >> 16) % FF;
        float av = 0.f, uv = 0.f;
        for (int k = 0; k < D; ++k) { const float x = bf2f(Hb[(size_t)row * D + k]); av += x * bfr(a.in[8][(size_t)k * 2 * FF + hc]); uv += x * bfr(a.in[8][(size_t)k * 2 * FF + FF + hc]); }
        const float ref = av / (1.0f + expf(-av)) * uv, got = bf2f(hid[(size_t)row * FF + hc]);
        flag_if(!(fabsf(got - ref) <= 0.02f * fabsf(ref) + 0.02f), flags, 2u); }
}
__device__ __forceinline__ void chk_res0(const Args& a, unsigned* flags) {
    const bf16* hid = (const bf16*)(a.ws + WS_BIG); const float* Z = (const float*)(a.ws + WS_Z); const float* mod = (const float*)(a.ws + WS_MOD);
    CHK_LOOP(4096u) { const unsigned h = hash_u(sidx * 7u + 3u); const int row = h % TT, col = (h >> 16) % D;
        float y = 0.f;
        for (int k = 0; k < FF; ++k) y += bf2f(hid[(size_t)row * FF + k]) * bfr(a.in[9][(size_t)k * D + col]);
        const float xin = (row < TL) ? a.in[0][(size_t)row * D + col] : a.in[2][(size_t)(row - TL) * D + col];
        const int set = (row < TL) ? (row >> 11) : 16;
        const float ref = DN_ALPHA * xin + 0.5f * mod[(size_t)set * MODSET + 2 * D + col] * y, got = Z[(size_t)row * D + col];
        flag_if(!(fabsf(got - ref) <= 5e-3f * fabsf(ref) + 5e-3f), flags, 4u); }
}
__device__ __forceinline__ void chk_ln(const Args& a, unsigned* flags) {
    const bf16* Hb = (const bf16*)(a.ws + WS_HB); const float* Z = (const float*)(a.ws + WS_Z); const float* mod = (const float*)(a.ws + WS_MOD);
    CHK_LOOP(1024u) { const unsigned h = hash_u(sidx * 11u + 4u); const int row = h % TT, col = (h >> 16) % D;
        float s = 0.f; for (int k = 0; k < D; ++k) s += Z[(size_t)row * D + k];
        const float mean = s / D; float q = 0.f; for (int k = 0; k < D; ++k) { const float d = Z[(size_t)row * D + k] - mean; q += d * d; }
        const float rstd = 1.0f / sqrtf(q / D + LN_EPS);
        const float x = (Z[(size_t)row * D + col] - mean) * rstd * a.in[6][col] + a.in[7][col];
        const int set = (row < TL) ? (row >> 11) : 16;
        const float ref = x * (1.0f + mod[(size_t)set * MODSET + 4 * D + col]) + mod[(size_t)set * MODSET + 3 * D + col], got = bf2f(Hb[(size_t)row * D + col]);
        flag_if(!(fabsf(got - ref) <= 0.01f * fabsf(ref) + 0.01f), flags, 8u); }
}
__device__ __forceinline__ float chk_dot(const Args& a, const bf16* Hb, int row, int col) { float v = 0.f; for (int k = 0; k < D; ++k) v += bf2f(Hb[(size_t)row * D + k]) * bfr(a.in[10][(size_t)k * 3 * D + col]); return v; }
__device__ __forceinline__ void chk_qkv(const Args& a, unsigned* flags) {
    const bf16* Hb = (const bf16*)(a.ws + WS_HB); const bf16* Q = (const bf16*)(a.ws + WS_BIG); const bf16* K = Q + (size_t)TT * D; const bf16* VT = K + (size_t)TT * D;
    CHK_LOOP(4096u) { const unsigned h = hash_u(sidx * 13u + 5u); const int row = h % TT, which = (h >> 16) % 3, head = (h >> 18) & 15, d = (h >> 22) & 63;
        float ref, got;
        if (which == 2) { ref = chk_dot(a, Hb, row, 2 * D + head * 64 + d); got = bf2f(VT[(size_t)(head * 64 + d) * TT + row]); }
        else { const int half = d >> 5, dd = d & 31, f = dd & 15; const bool x1 = dd < 16; const int d1 = half * 32 + f, d2 = d1 + 16;
            const float v1 = chk_dot(a, Hb, row, which * D + head * 64 + d1), v2 = chk_dot(a, Hb, row, which * D + head * 64 + d2);
            float c = 1.f, s = 0.f; if (row < TL) { const int t = row & 2047, pos = half ? (t & 63) : (t >> 6); const float ang = (float)pos * a.inv_freq[f]; c = cosf(ang); s = sinf(ang); }
            ref = x1 ? (v1 * c - v2 * s) : (v2 * c + v1 * s); if (which == 0) ref *= 0.125f;
            got = bf2f((which == 0 ? Q : K)[(size_t)row * D + head * 64 + d]); }
        flag_if(!(fabsf(got - ref) <= 0.02f * fabsf(ref) + 0.02f), flags, 16u); }
}
__device__ __forceinline__ void chk_attn(const Args& a, unsigned* flags) {
    const bf16* O = (const bf16*)(a.ws + WS_HB); const bf16* Q = (const bf16*)(a.ws + WS_BIG); const bf16* K = Q + (size_t)TT * D; const bf16* VT = K + (size_t)TT * D;
    CHK_LOOP(4096u) { const unsigned h = hash_u(sidx * 17u + 6u); const int row = h % TT, head = (h >> 16) & 15, d = (h >> 20) & 63;
        const bf16* qp = Q + (size_t)row * D + head * 64; const bf16* vrow = VT + (size_t)(head * 64 + d) * TT;
        float m = -1e30f, l = 0.f, o = 0.f; int b;
        if (row < TL) { b = row >> 11; const int t = row & 2047, r = t >> 6, qc = t & 63, rs = min(max(r - 4, 0), 24), w0 = min(max(qc - 8, 0), 48);
            for (int i = 0; i < 8; ++i) for (int kc = w0; kc < w0 + 16; ++kc) { const int kt = b * SEQ + (rs + i) * 64 + kc; const bf16* kp = K + (size_t)kt * D + head * 64;
                float s = 0.f; for (int e = 0; e < 64; ++e) s += bf2f(qp[e]) * bf2f(kp[e]);
                s += a.in[12][(size_t)head * 465 + (rs + i - r + 7) * 31 + (kc - qc + 15)];
                const float mn = fmaxf(m, s), sc = expf(m - mn), p = expf(s - mn); l = l * sc + p; o = o * sc + p * bf2f(vrow[kt]); m = mn; } }
        else b = (row - TL) >> 8;
        for (int c = 0; c < CTXL; ++c) { const int kt = TL + b * CTXL + c; const bf16* kp = K + (size_t)kt * D + head * 64;
            float s = 0.f; for (int e = 0; e < 64; ++e) s += bf2f(qp[e]) * bf2f(kp[e]);
            const float mn = fmaxf(m, s), sc = expf(m - mn), p = expf(s - mn); l = l * sc + p; o = o * sc + p * bf2f(vrow[kt]); m = mn; }
        const float ref = o / l, got = bf2f(O[(size_t)row * D + head * 64 + d]);
        flag_if(!(fabsf(got - ref) <= 0.03f * fabsf(ref) + 0.004f), flags, 32u); }
}

__global__ void __launch_bounds__(NTHR, 2) mega_fwd(Args args) {
    extern __shared__ __attribute__((aligned(16))) unsigned char lds_raw[];
    LAS unsigned char* lds = (LAS unsigned char*)lds_raw;
    cg::grid_group grid = cg::this_grid();
    const int tid = threadIdx.x, lane = tid & 63, wave = __builtin_amdgcn_readfirstlane(tid >> 6);
    const int G = gridDim.x, bx = blockIdx.x;
    unsigned char* ws = args.ws;
    const float* mod = (const float*)(ws + WS_MOD);
    float* Z = (float*)(ws + WS_Z); const float* stats = (const float*)(ws + WS_STATS);
    const float* ident = (const float*)(ws + WS_IDENT);
    bf16* Hb = (bf16*)(ws + WS_HB); bf16* BIG = (bf16*)(ws + WS_BIG);
    const float* ln_g = args.in[6]; const float* ln_b = args.in[7];
    const int lo = args.ph_lo, hi = args.ph_hi;
    int step = 0;
#define GRID_SYNC() do { asm volatile("s_waitcnt vmcnt(0)" ::: "memory"); __syncthreads(); \
    if (threadIdx.x < 64) { __builtin_amdgcn_fence(__ATOMIC_RELEASE, "agent"); asm volatile("s_waitcnt vmcnt(0)" ::: "memory"); } \
    grid.sync(); \
    if (threadIdx.x < 64) { __builtin_amdgcn_fence(__ATOMIC_ACQUIRE, "agent"); asm volatile("s_waitcnt vmcnt(0)" ::: "memory"); } __syncthreads(); } while (0)
#ifndef KEEPMASK
#define KEEPMASK 0xffffffffu
#endif
#define RUN(id, ...) do { if constexpr ((KEEPMASK >> (id)) & 1u) { if (step >= lo && step < hi) { { int tid = threadIdx.x; asm volatile("" : "+v"(tid)); const int lane = tid & 63, wave = __builtin_amdgcn_readfirstlane(tid >> 6); (void)lane; (void)wave; __VA_ARGS__; } if (step + 1 < hi) { GRID_SYNC(); } } } ++step; } while (0)

    RUN(0, phase0(args, lds, tid, lane, wave));
#if (DBG_CHECK & 1)
    RUN(16, chk_mod(args, (unsigned*)ws));
#endif
    RUN(1, ln_pass(args, 0, TT, ident, ident + 1024, mod, 0, lane, wave));
    const float* pg = ident; const float* pb = ident + 1024;
#pragma nounroll
    for (int i = 0; i < DEPTH; ++i) {
        const float* modl = mod + (size_t)i * NSET * MODSET;
        const int jl = i >> 1;
        const int M1 = (i <= 2) ? TT : TL;
        const int Mm = (i <= 1) ? TT : TL;
        const int M2 = (i <= 1) ? TT : TL;
        RUN(2, { pg8::Gemm g{Hb, (const bf16*)(ws + WS_W1) + (size_t)(2 * i) * 2 * FF * D, M1, 2 * FF, D}; pg8::StaticOrder S; S.init(M1, 2 * FF, G, bx);
              pg8::EpiSwiglu E{BIG, FF}; pg8::gemm_phase<pg8::EpiSwiglu, pg8::StaticOrder, true, true>(lds, g, S, E, tid); });
#if (DBG_CHECK & 2)
        if (i == 0) RUN(17, chk_gemm1(args, (unsigned*)ws)); else ++step;
#endif
        RUN(3, { pg8::Gemm g{BIG, (const bf16*)(ws + WS_W2) + (size_t)(2 * i) * D * FF, M1, D, FF}; pg8::StaticOrder S; S.init(M1, D, G, bx);
              pg8::EpiRes E{Z, stats, pg, pb, modl + 2 * D, 0.5f, DN_ALPHA}; pg8::gemm_phase<pg8::EpiRes, pg8::StaticOrder, true, true>(lds, g, S, E, tid); });
#if (DBG_CHECK & 4)
        if (i == 0) RUN(18, chk_res0(args, (unsigned*)ws)); else ++step;
#endif
        pg = ln_g + (size_t)(i * 3 + 0) * D; pb = ln_b + (size_t)(i * 3 + 0) * D;
        RUN(4, ln_pass(args, 1, (i == 2) ? TT : Mm, pg, pb, modl, 3, lane, wave));
#if (DBG_CHECK & 8)
        if (i == 0) RUN(19, chk_ln(args, (unsigned*)ws)); else ++step;
#endif
        if ((i & 1) == 0) {
            RUN(5, { { pg8::Gemm g{Hb, (const bf16*)(ws + WS_WQK) + (size_t)jl * 2048 * D, TT, 2048, D}; pg8::StaticOrder S; S.init(TT, 2048, G, bx);
                    pg8::EpiQK E{BIG, BIG + (size_t)TT * D, (const float*)(ws + WS_ROPE), (const float*)(ws + WS_ROPE) + 1024};
                    pg8::gemm_phase<pg8::EpiQK, pg8::StaticOrder, true, true>(lds, g, S, E, tid); }
                  { pg8::Gemm g{(const bf16*)(ws + WS_WV) + (size_t)jl * D * D, Hb, D, TT, D}; pg8::StaticOrder S; S.init(D, TT, G, bx);
                    pg8::EpiStoreBf16 E{BIG + (size_t)2 * TT * D, TT};
                    pg8::gemm_phase<pg8::EpiStoreBf16, pg8::StaticOrder, true, true>(lds, g, S, E, tid); } });
#if (DBG_CHECK & 16)
            if (i == 0) RUN(20, chk_qkv(args, (unsigned*)ws)); else ++step;
#endif
            RUN(6, attn_phase(args, lds, args.in[12] + (size_t)jl * NH * 465, i == 0, tid, lane, wave));
#if (DBG_CHECK & 32)
            if (i == 0) RUN(21, chk_attn(args, (unsigned*)ws)); else ++step;
#endif
            RUN(7, { pg8::Gemm g{Hb, (const bf16*)(ws + WS_WO) + (size_t)jl * D * D, Mm, D, D}; pg8::StaticOrder S; S.init(Mm, D, G, bx);
                  pg8::EpiRes E{Z, stats, pg, pb, modl + 5 * D, 1.0f, DN_ALPHA}; pg8::gemm_phase<pg8::EpiRes, pg8::StaticOrder, true, true>(lds, g, S, E, tid); });
        } else {
            RUN(8, { pg8::Gemm g{Hb, (const bf16*)(ws + WS_WC) + (size_t)jl * 3 * D * D, Mm, 3 * D, D}; pg8::StaticOrder S; S.init(Mm, 3 * D, G, bx);
                  pg8::EpiConvIn E{BIG, BIG + (size_t)TT * D}; pg8::gemm_phase<pg8::EpiConvIn, pg8::StaticOrder, true, true>(lds, g, S, E, tid); });
            RUN(9, conv_phase(args, args.in[14] + (size_t)jl * 3 * D, Mm, tid));
            RUN(10, { pg8::Gemm g{Hb, (const bf16*)(ws + WS_WCO) + (size_t)jl * D * D, Mm, D, D}; pg8::StaticOrder S; S.init(Mm, D, G, bx);
                  pg8::EpiRes E{Z, stats, pg, pb, modl + 5 * D, 1.0f, DN_ALPHA}; pg8::gemm_phase<pg8::EpiRes, pg8::StaticOrder, true, true>(lds, g, S, E, tid); });
        }
        pg = ln_g + (size_t)(i * 3 + 1) * D; pb = ln_b + (size_t)(i * 3 + 1) * D;
        RUN(11, ln_pass(args, 1, M2, pg, pb, modl, 6, lane, wave));
        RUN(12, { pg8::Gemm g{Hb, (const bf16*)(ws + WS_W1) + (size_t)(2 * i + 1) * 2 * FF * D, M2, 2 * FF, D}; pg8::StaticOrder S; S.init(M2, 2 * FF, G, bx);
              pg8::EpiSwiglu E{BIG, FF}; pg8::gemm_phase<pg8::EpiSwiglu, pg8::StaticOrder, true, true>(lds, g, S, E, tid); });
        RUN(13, { pg8::Gemm g{BIG, (const bf16*)(ws + WS_W2) + (size_t)(2 * i + 1) * D * FF, M2, D, FF}; pg8::StaticOrder S; S.init(M2, D, G, bx);
              pg8::EpiRes E{Z, stats, pg, pb, modl + 8 * D, 0.5f, DN_ALPHA}; pg8::gemm_phase<pg8::EpiRes, pg8::StaticOrder, true, true>(lds, g, S, E, tid); });
        pg = ln_g + (size_t)(i * 3 + 2) * D; pb = ln_b + (size_t)(i * 3 + 2) * D;
        if (i < DEPTH - 1) { const int Mn = (i + 1 <= 2) ? TT : TL; RUN(14, ln_pass(args, 1, Mn, pg, pb, mod + (size_t)(i + 1) * NSET * MODSET, 0, lane, wave)); }
        else RUN(15, ln_pass(args, 2, TL, pg, pb, modl, 0, lane, wave));
    }
#if DBG_CHECK
    if (blockIdx.x == 0 && threadIdx.x == 0) { const unsigned mask = __hip_atomic_load((unsigned*)ws, __ATOMIC_RELAXED, __HIP_MEMORY_SCOPE_AGENT); if (mask) args.out[0] = 1000.0f + 100.0f * (float)mask; }
#endif
#undef RUN
}

extern "C" void kernel_launch(void* const* d_in, const int* in_sizes, int n_in, void* d_out, int out_size, void* d_ws, size_t ws_size, hipStream_t stream) {
    static int grid = 0;
    if (grid == 0) {
        if (n_in != 16 || ws_size < WS_END) { fprintf(stderr, "kernel_launch: need 16 inputs and >= %zu bytes of workspace (got %d, %zu)\n", (size_t)WS_END, n_in, ws_size); grid = -1; return; }
        int dev = 0, cus = 0, per_cu = 0;
        hipGetDevice(&dev); hipDeviceGetAttribute(&cus, hipDeviceAttributeMultiprocessorCount, dev);
        if (hipFuncSetAttribute((const void*)mega_fwd, hipFuncAttributeMaxDynamicSharedMemorySize, LDS_BYTES) != hipSuccess) { fprintf(stderr, "kernel_launch: hipFuncSetAttribute failed\n"); grid = -1; return; }
        if (hipOccupancyMaxActiveBlocksPerMultiprocessor(&per_cu, (const void*)mega_fwd, NTHR, LDS_BYTES) != hipSuccess || per_cu < 1) { fprintf(stderr, "kernel_launch: occupancy query gave %d\n", per_cu); per_cu = 1; }
        (void)hipGetLastError();
        grid = cus * per_cu;
        fprintf(stderr, "kernel_launch: grid %d (cus %d x %d)\n", grid, cus, per_cu);
    }
    if (grid < 0) return;
    Args a{};
    for (int i = 0; i < 16; ++i) a.in[i] = (const float*)d_in[i];
    a.out = (float*)d_out; a.ws = (unsigned char*)d_ws;
    for (int f = 0; f < 16; ++f) a.inv_freq[f] = (float)pow(10000.0, -(double)f / 16.0);
    a.ph_lo = 0; a.ph_hi = 1 << 20;
    void* kargs[] = {&a};
    hipError_t e = hipLaunchCooperativeKernel((const void*)mega_fwd, dim3(grid), dim3(NTHR), kargs, LDS_BYTES, stream);
    if (e != hipSuccess) fprintf(stderr, "kernel_launch: cooperative launch failed: %s (grid %d)\n", hipGetErrorString(e), grid);
}
```
